# Optimizing an MI355X kernel written in HIP

```python
import math
import jax, jax.numpy as jnp
from jax import lax
import numpy as np

D_MODEL = 1024
BATCH = 8
SEQ = 2048
DEPTH = 1
DEC_BATCH = 128
DEC_SEQ = 1
PAST_LEN = 16384
PAGE_SIZE = 128

RWKV_WIDTH = D_MODEL // 2
RWKV_HEAD = 64
RWKV_HEADS = RWKV_WIDTH // RWKV_HEAD
DECAY_LORA = 64
AAA_LORA = 64
GATE_LORA = 128
LNX_EPS = 64e-5
S5_WIDTH = D_MODEL // 2
S5_GROUP = 16
S5_GROUPS = S5_WIDTH // S5_GROUP
S5_STATE = 64
FFN_DIM = 2816
NORM_EPS = 1e-6
N_BRANCH = 2
RWKV_COLS = 3 * RWKV_WIDTH + DECAY_LORA + AAA_LORA + GATE_LORA
IN_COLS = RWKV_COLS + S5_WIDTH + N_BRANCH * D_MODEL

kernel_name = 'rwkv7_s5_gated_macaron_step'


def rmsnorm(x, g):
    xf = x.astype(jnp.float32)
    y = xf * lax.rsqrt(jnp.mean(xf * xf, axis=-1, keepdims=True) + NORM_EPS)
    return (y * g.astype(jnp.float32)).astype(x.dtype)


def swiglu(x, w_gate, w_up, w_down):
    return (jax.nn.silu(x @ w_gate) * (x @ w_up)) @ w_down


def token_shift(f, prev):
    return jnp.concatenate([prev[:, None, :], f[:, :-1, :]], axis=1)


def rwkv7_recurrence(r, w, k, v, kk, b, S0):
    def step(S, inp):
        r_t, w_t, k_t, v_t, kk_t, b_t = inp
        sa = jnp.einsum('bhvk,bhk->bhv', S, -kk_t)
        S = (S * w_t[:, :, None, :] + sa[..., None] * b_t[:, :, None, :]
             + v_t[..., None] * k_t[:, :, None, :])
        o = jnp.einsum('bhvk,bhk->bhv', S, r_t)
        return S, o
    xs = tuple(jnp.moveaxis(t, 1, 0) for t in (r, w, k, v, kk, b))
    S, o = lax.scan(step, S0, xs)
    return jnp.moveaxis(o, 0, 1), S


def rwkv7_branch(f, S0, p):
    B, L, _ = f.shape
    H, N, W = RWKV_HEADS, RWKV_HEAD, RWKV_WIDTH
    f = f.astype(jnp.float32)
    r = f[..., 0:W]
    k = f[..., W:2 * W]
    v = f[..., 2 * W:3 * W]
    o0 = 3 * W
    wd = f[..., o0:o0 + DECAY_LORA]
    ad = f[..., o0 + DECAY_LORA:o0 + DECAY_LORA + AAA_LORA]
    gd = f[..., o0 + DECAY_LORA + AAA_LORA:]
    w_log = -jax.nn.softplus(-(p['w0'] + jnp.tanh(wd) @ p['w_up'])) - 0.5
    decay = jnp.exp(-jnp.exp(w_log))
    a = jax.nn.sigmoid(p['a0'] + ad @ p['a_up'])
    g = jax.nn.sigmoid(gd) @ p['g_up']
    heads = lambda t: t.reshape(B, L, H, N)
    kk = heads(k * p['k_k'])
    kk = kk / jnp.maximum(jnp.sqrt(jnp.sum(kk * kk, axis=-1, keepdims=True)), 1e-12)
    k = k * (1.0 + (a - 1.0) * p['k_a'])
    r_h, k_h, v_h, a_h = heads(r), heads(k), heads(v), heads(a)
    o, S = rwkv7_recurrence(r_h, heads(decay), k_h, v_h, kk, kk * a_h, S0.astype(jnp.float32))
    mu = jnp.mean(o, axis=-1, keepdims=True)
    var = jnp.mean(jnp.square(o - mu), axis=-1, keepdims=True)
    o = ((o - mu) * lax.rsqrt(var + LNX_EPS)).reshape(B, L, W) * p['lnx_w'] + p['lnx_b']
    bonus = jnp.sum(r_h * k_h * p['r_k'], axis=-1, keepdims=True) * v_h
    return (o + bonus.reshape(B, L, W)) * g, S


def s5_branch(u, xr0, xi0, p):
    B, L, _ = u.shape
    f32 = jnp.float32
    uf = u.astype(f32)
    ug = uf.reshape(B, L, S5_GROUPS, S5_GROUP)
    lam_r = p['A_re'].astype(f32)
    lam_i = p['A_im'].astype(f32)
    dt = jnp.exp(p['log_dt'].astype(f32))[:, None]
    mag = jnp.exp(lam_r * dt)
    ab_r, ab_i = mag * jnp.cos(lam_i * dt), mag * jnp.sin(lam_i * dt)
    den = lam_r * lam_r + lam_i * lam_i
    q_r = ((ab_r - 1.0) * lam_r + ab_i * lam_i) / den
    q_i = (ab_i * lam_r - (ab_r - 1.0) * lam_i) / den
    B_re, B_im = p['B_re'].astype(f32), p['B_im'].astype(f32)
    bb_r = q_r[..., None] * B_re - q_i[..., None] * B_im
    bb_i = q_r[..., None] * B_im + q_i[..., None] * B_re
    bu_r = jnp.einsum('blgh,gph->blgp', ug, bb_r)
    bu_i = jnp.einsum('blgh,gph->blgp', ug, bb_i)
    xr0 = xr0.astype(f32)
    xi0 = xi0.astype(f32)
    bu_r = bu_r.at[:, 0].add(ab_r * xr0 - ab_i * xi0)
    bu_i = bu_i.at[:, 0].add(ab_r * xi0 + ab_i * xr0)
    a_r = jnp.broadcast_to(ab_r, (1, L, S5_GROUPS, S5_STATE))
    a_i = jnp.broadcast_to(ab_i, (1, L, S5_GROUPS, S5_STATE))

    def combine(e1, e2):
        a1r, a1i, b1r, b1i = e1
        a2r, a2i, b2r, b2i = e2
        return (a2r * a1r - a2i * a1i, a2r * a1i + a2i * a1r,
                a2r * b1r - a2i * b1i + b2r, a2r * b1i + a2i * b1r + b2i)

    _, _, xr, xi = lax.associative_scan(combine, (a_r, a_i, bu_r, bu_i), axis=1)
    C_re, C_im = p['C_re'].astype(f32), p['C_im'].astype(f32)
    y = jnp.einsum('blgp,ghp->blgh', xr, C_re) - jnp.einsum('blgp,ghp->blgh', xi, C_im)
    y = y.reshape(B, L, S5_WIDTH) + p['D_skip'] * uf
    z = jax.nn.gelu(y)
    return z * jax.nn.sigmoid(z @ p['w_glu']), xr[:, -1], xi[:, -1]


def hybrid_layer(x, shift0, wkv0, s5r0, s5i0, p):
    x = x + 0.5 * swiglu(rmsnorm(x, p['g_ffn1']), p['ffn1_gate'], p['ffn1_up'], p['ffn1_down'])
    h = rmsnorm(x, p['g_mix'])
    proj = h @ p['w_in']
    f_rwkv = proj[..., :RWKV_COLS]
    u = proj[..., RWKV_COLS:RWKV_COLS + S5_WIDTH]
    gates = jax.nn.sigmoid(proj[..., RWKV_COLS + S5_WIDTH:].astype(jnp.float32))
    shifted = token_shift(f_rwkv, shift0.astype(f_rwkv.dtype))
    f_mix = f_rwkv + p['mu_shift'] * (shifted - f_rwkv)
    y_a, wkv = rwkv7_branch(f_mix, wkv0, p)
    y_b, s5r, s5i = s5_branch(u, s5r0, s5i0, p)
    merged = gates[..., :D_MODEL] * (y_a @ p['w_a_up']) + gates[..., D_MODEL:] * (y_b @ p['w_b_up'])
    x = x + (merged @ p['w_out']).astype(x.dtype)
    x = x + 0.5 * swiglu(rmsnorm(x, p['g_ffn2']), p['ffn2_gate'], p['ffn2_up'], p['ffn2_down'])
    return x, f_rwkv[:, -1], wkv, s5r, s5i


def setup_inputs(seed: int = 0) -> dict:
    key = jax.random.key(seed)
    ks = iter(jax.random.split(key, 64))
    f32 = jnp.float32

    def nrm(shape, scale):
        return scale * jax.random.normal(next(ks), shape, f32)

    def uni(shape, lo, hi):
        return jax.random.uniform(next(ks), shape, f32, lo, hi)

    W = RWKV_WIDTH
    n_idx = jnp.arange(S5_STATE, dtype=f32)
    return {
        'x_prompt': nrm((BATCH, SEQ, D_MODEL), 1.0),
        'x_sample': nrm((DEC_BATCH, DEC_SEQ, D_MODEL), 1.0),
        'state_shift': nrm((DEPTH, DEC_BATCH, RWKV_COLS), 1.0),
        'state_wkv': nrm((DEPTH, DEC_BATCH, RWKV_HEADS, RWKV_HEAD, RWKV_HEAD), 0.5),
        'state_s5_re': nrm((DEPTH, DEC_BATCH, S5_GROUPS, S5_STATE), 0.5),
        'state_s5_im': nrm((DEPTH, DEC_BATCH, S5_GROUPS, S5_STATE), 0.5),
        'g_ffn1': 1.0 + nrm((DEPTH, D_MODEL), 0.02),
        'ffn1_gate': nrm((DEPTH, D_MODEL, FFN_DIM), D_MODEL ** -0.5),
        'ffn1_up': nrm((DEPTH, D_MODEL, FFN_DIM), D_MODEL ** -0.5),
        'ffn1_down': nrm((DEPTH, FFN_DIM, D_MODEL), FFN_DIM ** -0.5),
        'g_mix': 1.0 + nrm((DEPTH, D_MODEL), 0.02),
        'w_in': nrm((DEPTH, D_MODEL, IN_COLS), D_MODEL ** -0.5),
        'mu_shift': uni((DEPTH, RWKV_COLS), 0.0, 1.0),
        'w0': uni((DEPTH, W), -6.0, -1.0),
        'w_up': nrm((DEPTH, DECAY_LORA, W), 0.1),
        'a0': nrm((DEPTH, W), 0.5),
        'a_up': nrm((DEPTH, AAA_LORA, W), AAA_LORA ** -0.5),
        'g_up': nrm((DEPTH, GATE_LORA, W), GATE_LORA ** -0.5),
        'k_k': 0.85 + nrm((DEPTH, W), 0.05),
        'k_a': 1.0 + nrm((DEPTH, W), 0.05),
        'r_k': nrm((DEPTH, RWKV_HEADS, RWKV_HEAD), 0.1),
        'lnx_w': 1.0 + nrm((DEPTH, W), 0.02),
        'lnx_b': nrm((DEPTH, W), 0.01),
        'A_re': -0.5 * jnp.exp(nrm((DEPTH, S5_GROUPS, S5_STATE), 0.05)),
        'A_im': jnp.pi * n_idx + nrm((DEPTH, S5_GROUPS, S5_STATE), 0.02),
        'log_dt': uni((DEPTH, S5_GROUPS), math.log(0.001), math.log(0.1)),
        'B_re': nrm((DEPTH, S5_GROUPS, S5_STATE, S5_GROUP), (2 * S5_GROUP) ** -0.5),
        'B_im': nrm((DEPTH, S5_GROUPS, S5_STATE, S5_GROUP), (2 * S5_GROUP) ** -0.5),
        'C_re': nrm((DEPTH, S5_GROUPS, S5_GROUP, S5_STATE), (2 * S5_STATE) ** -0.5),
        'C_im': nrm((DEPTH, S5_GROUPS, S5_GROUP, S5_STATE), (2 * S5_STATE) ** -0.5),
        'D_skip': nrm((DEPTH, S5_WIDTH), 1.0),
        'w_glu': nrm((DEPTH, S5_WIDTH, S5_WIDTH), S5_WIDTH ** -0.5),
        'w_a_up': nrm((DEPTH, RWKV_WIDTH, D_MODEL), RWKV_WIDTH ** -0.5),
        'w_b_up': nrm((DEPTH, S5_WIDTH, D_MODEL), S5_WIDTH ** -0.5),
        'w_out': nrm((DEPTH, D_MODEL, D_MODEL), D_MODEL ** -0.5),
        'g_ffn2': 1.0 + nrm((DEPTH, D_MODEL), 0.02),
        'ffn2_gate': nrm((DEPTH, D_MODEL, FFN_DIM), D_MODEL ** -0.5),
        'ffn2_up': nrm((DEPTH, D_MODEL, FFN_DIM), D_MODEL ** -0.5),
        'ffn2_down': nrm((DEPTH, FFN_DIM, D_MODEL), FFN_DIM ** -0.5),
        'g_final': 1.0 + nrm((D_MODEL,), 0.02),
    }


def reference(x_prompt, x_sample, state_shift, state_wkv, state_s5_re, state_s5_im,
              g_ffn1, ffn1_gate, ffn1_up, ffn1_down, g_mix, w_in, mu_shift,
              w0, w_up, a0, a_up, g_up, k_k, k_a, r_k, lnx_w, lnx_b,
              A_re, A_im, log_dt, B_re, B_im, C_re, C_im, D_skip, w_glu,
              w_a_up, w_b_up, w_out, g_ffn2, ffn2_gate, ffn2_up, ffn2_down, g_final):
    p = {'g_ffn1': g_ffn1, 'ffn1_gate': ffn1_gate, 'ffn1_up': ffn1_up, 'ffn1_down': ffn1_down,
         'g_mix': g_mix, 'w_in': w_in, 'mu_shift': mu_shift,
         'w0': w0, 'w_up': w_up, 'a0': a0, 'a_up': a_up, 'g_up': g_up,
         'k_k': k_k, 'k_a': k_a, 'r_k': r_k, 'lnx_w': lnx_w, 'lnx_b': lnx_b,
         'A_re': A_re, 'A_im': A_im, 'log_dt': log_dt, 'B_re': B_re, 'B_im': B_im,
         'C_re': C_re, 'C_im': C_im, 'D_skip': D_skip, 'w_glu': w_glu,
         'w_a_up': w_a_up, 'w_b_up': w_b_up, 'w_out': w_out,
         'g_ffn2': g_ffn2, 'ffn2_gate': ffn2_gate, 'ffn2_up': ffn2_up, 'ffn2_down': ffn2_down}
    bp = x_prompt.shape[0]
    f32 = jnp.float32
    hp, hs = x_prompt, x_sample
    sh_p, wk_p, sr_p, si_p = [], [], [], []
    sh_s, wk_s, sr_s, si_s = [], [], [], []
    for layer in range(DEPTH):
        pl = {name: arr[layer] for name, arr in p.items()}
        hp, a1, a2, a3, a4 = hybrid_layer(
            hp,
            jnp.zeros((bp, RWKV_COLS), f32),
            jnp.zeros((bp, RWKV_HEADS, RWKV_HEAD, RWKV_HEAD), f32),
            jnp.zeros((bp, S5_GROUPS, S5_STATE), f32),
            jnp.zeros((bp, S5_GROUPS, S5_STATE), f32), pl)
        sh_p.append(a1); wk_p.append(a2); sr_p.append(a3); si_p.append(a4)
        hs, b1, b2, b3, b4 = hybrid_layer(
            hs, state_shift[layer], state_wkv[layer], state_s5_re[layer], state_s5_im[layer], pl)
        sh_s.append(b1); wk_s.append(b2); sr_s.append(b3); si_s.append(b4)
    y_prompt = rmsnorm(hp, g_final)
    y_sample = rmsnorm(hs, g_final)
    new_shift_prompt = jnp.stack(sh_p, 0).astype(state_shift.dtype)
    new_wkv_prompt = jnp.stack(wk_p, 0).astype(state_wkv.dtype)
    new_s5_re_prompt = jnp.stack(sr_p, 0).astype(state_s5_re.dtype)
    new_s5_im_prompt = jnp.stack(si_p, 0).astype(state_s5_im.dtype)
    new_shift_sample = jnp.stack(sh_s, 0).astype(state_shift.dtype)
    new_wkv_sample = jnp.stack(wk_s, 0).astype(state_wkv.dtype)
    new_s5_re_sample = jnp.stack(sr_s, 0).astype(state_s5_re.dtype)
    new_s5_im_sample = jnp.stack(si_s, 0).astype(state_s5_im.dtype)
    return (y_prompt, y_sample, new_shift_prompt, new_wkv_prompt, new_s5_re_prompt, new_s5_im_prompt,
            new_shift_sample, new_wkv_sample, new_s5_re_sample, new_s5_im_sample)
```

```cpp
#include <hip/hip_runtime.h>
#include <hip/hip_cooperative_groups.h>
#include <cstdio>
namespace cg = cooperative_groups;

#define LAS __attribute__((address_space(3)))
typedef unsigned short bf16_t;
typedef short bf16x8 __attribute__((ext_vector_type(8)));
typedef float f32x4 __attribute__((ext_vector_type(4)));
typedef float f32x2 __attribute__((ext_vector_type(2)));
typedef unsigned u32x4 __attribute__((ext_vector_type(4)));
typedef unsigned u32x2 __attribute__((ext_vector_type(2)));

constexpr int DM = 1024, MPROMPT = 16384, NSAMP = 128, MV = 16512, MP = 16640;
constexpr int FF = 2816, RC = 1792;
constexpr int NTHR = 512;
constexpr int LDS_BYTES = 131072 + 16;
#ifndef PHMASK
#define PHMASK 0xffffffffu
#endif
#define PH(n) if (PHMASK & (1u << (n)))

constexpr size_t WS_WFFN = 0;
constexpr size_t WS_WDT = WS_WFFN + (size_t)5632 * 1024 * 2;
constexpr size_t WS_WIN = WS_WFFN + (size_t)17301504;
constexpr size_t WS_WL = WS_WIN + (size_t)4352 * 1024 * 2;
constexpr size_t WS_WGLU = WS_WL + (size_t)1536 * 256 * 2;
constexpr size_t WS_WA = WS_WGLU + (size_t)512 * 512 * 2;
constexpr size_t WS_WB = WS_WA + (size_t)1024 * 512 * 2;
constexpr size_t WS_WOUT = WS_WB + (size_t)1024 * 512 * 2;
constexpr size_t WS_S5W1 = WS_WOUT + (size_t)1024 * 1024 * 2;
constexpr size_t WS_S5W2 = WS_S5W1 + (size_t)8192 * 256 * 2;
constexpr size_t WS_KT = WS_S5W2 + (size_t)8192 * 384 * 2;
constexpr size_t WS_BBT = WS_KT + (size_t)131072 * 4;
constexpr size_t WS_ABAR = WS_BBT + (size_t)65536 * 4;
constexpr size_t WS_ABAR16 = WS_ABAR + (size_t)4096 * 4;
constexpr size_t WS_RS1 = WS_ABAR16 + (size_t)4096 * 4;
constexpr size_t WS_SS2 = WS_RS1 + (size_t)MP * 4;
constexpr size_t WS_SS3 = WS_SS2 + (size_t)MP * 64;
constexpr size_t WS_SS4 = WS_SS3 + (size_t)MP * 64;
constexpr size_t WS_BONUS = WS_SS4 + (size_t)MP * 64;
constexpr size_t WS_US = WS_BONUS + (size_t)MP * 8 * 4;
constexpr size_t WS_RX = WS_US + (size_t)128 * 512 * 4;
constexpr size_t WS_RH = WS_RX + (size_t)MP * 1024 * 2;
constexpr size_t RH_F = 0, RH_AS5 = (size_t)MP * RC * 2, RH_LIN = RH_AS5 + (size_t)32768 * 384 * 2, RH_MG = (size_t)MP * 1024 * 2;
constexpr size_t WS_RG = WS_RH + (size_t)MP * FF * 2;
constexpr size_t WS_Z = WS_RG + (size_t)MP * 2048 * 2;
constexpr size_t WS_CTL = WS_Z + (size_t)MP * 512 * 2;
constexpr size_t WS_PCNT = WS_CTL + 16384;
constexpr size_t WS_XSLOT = WS_CTL + 32768;
constexpr size_t WS_SLAB = WS_XSLOT + (size_t)16384 * 4 * 4;
constexpr size_t WS_END = WS_SLAB + (size_t)11 * 128 * 1024 * 4;
static_assert(RH_LIN + (size_t)MP * 256 * 2 <= (size_t)MP * FF * 2, "R_H overflow");
static_assert(WS_END <= (size_t)268435456, "workspace plan exceeds 256 MiB");

constexpr size_t O_Y = 0, O_SHP = 16908288, O_WKVP = 16922624, O_S5RP = 17184768, O_S5IP = 17201152, O_SHS = 17217536, O_WKVS = 17446912, O_S5RS = 21641216, O_S5IS = 21903360;

struct Params {
    const float* in[40];
    float* out;
    unsigned char* ws;
};

typedef __bf16 bf16x2_t __attribute__((ext_vector_type(2)));
__device__ __forceinline__ unsigned cvt_pk_bf16(float lo, float hi) { const f32x2 v = {lo, hi}; const bf16x2_t b = __builtin_convertvector(v, bf16x2_t); return __builtin_bit_cast(unsigned, b); }
__device__ __forceinline__ float bf_lo(unsigned w) { return __uint_as_float(w << 16); }
__device__ __forceinline__ float bf_hi(unsigned w) { return __uint_as_float(w & 0xffff0000u); }
__device__ __forceinline__ float sigmoidf_(float x) { return __builtin_amdgcn_rcpf(1.0f + __expf(-x)); }
__device__ __forceinline__ float siluf_(float x) { return x * sigmoidf_(x); }
__device__ __forceinline__ float tanhf_(float x) { return 1.0f - 2.0f * __builtin_amdgcn_rcpf(1.0f + __expf(2.0f * x)); }
__device__ __forceinline__ float geluf_(float y) { return y * sigmoidf_(1.5957691216f * (y + 0.044715f * y * y * y)); }
__device__ __forceinline__ void store8(bf16_t* p, f32x4 a, f32x4 b) { u32x4 w; w.x = cvt_pk_bf16(a[0], a[1]); w.y = cvt_pk_bf16(a[2], a[3]); w.z = cvt_pk_bf16(b[0], b[1]); w.w = cvt_pk_bf16(b[2], b[3]); *(u32x4*)p = w; }
__device__ __forceinline__ void load8(const bf16_t* p, f32x4& a, f32x4& b) { const u32x4 w = *(const u32x4*)p; a = (f32x4){bf_lo(w.x), bf_hi(w.x), bf_lo(w.y), bf_hi(w.y)}; b = (f32x4){bf_lo(w.z), bf_hi(w.z), bf_lo(w.w), bf_hi(w.w)}; }
__device__ __forceinline__ f32x4 load4bf(const bf16_t* p) { const u32x2 w = *(const u32x2*)p; return (f32x4){bf_lo(w.x), bf_hi(w.x), bf_lo(w.y), bf_hi(w.y)}; }
__device__ __forceinline__ void store4bf(bf16_t* p, f32x4 a) { u32x2 w; w.x = cvt_pk_bf16(a[0], a[1]); w.y = cvt_pk_bf16(a[2], a[3]); *(u32x2*)p = w; }
__device__ __forceinline__ float red16(float x) { x += __shfl_xor(x, 1); x += __shfl_xor(x, 2); x += __shfl_xor(x, 4); x += __shfl_xor(x, 8); return x; }
__device__ __forceinline__ float red64(float x) { x = red16(x); x += __shfl_xor(x, 16); x += __shfl_xor(x, 32); return x; }
__device__ __forceinline__ float row_rs(const float* ssp, int row) { const f32x4 a = *(const f32x4*)(ssp + (size_t)row * 16), b = *(const f32x4*)(ssp + (size_t)row * 16 + 4), c = *(const f32x4*)(ssp + (size_t)row * 16 + 8), d = *(const f32x4*)(ssp + (size_t)row * 16 + 12);
    const f32x4 t = (a + b) + (c + d); return rsqrtf(((t[0] + t[1]) + (t[2] + t[3])) * (1.0f / 1024.0f) + 1e-6f); }
#define DPP_ADD(x, ctrl) x += __int_as_float(__builtin_amdgcn_update_dpp(0, __float_as_int(x), ctrl, 0xf, 0xf, true))
__device__ __forceinline__ float dpp_allreduce16(float x) { DPP_ADD(x, 0xB1); DPP_ADD(x, 0x4E); DPP_ADD(x, 0x141); DPP_ADD(x, 0x140); return x; }

constexpr int BM = 256, BK = 64, HALF = 128, HTB = HALF * BK * 2, NXCD = 8, WGM = 4;
__device__ __forceinline__ int lds_byte(int r, int c) { const int st = (r >> 4) * 2 + (c >> 5), rr = r & 15, cc = c & 31, ob = rr * 64 + cc * 2; return st * 1024 + (ob ^ (((ob >> 9) & 1) << 5)); }
__device__ __forceinline__ void stage_rc(int b, int& R, int& C) { const int st = b / 1024, sb = b % 1024, swz = sb ^ (((sb >> 9) & 1) << 5); R = (st >> 1) * 16 + swz / 64; C = (st & 1) * 32 + (swz % 64) / 2; }
__device__ __forceinline__ int perm32(int rho) { const int n = rho >> 4, i = rho & 15; return 8 * (i >> 2) + 4 * n + (i & 3); }

struct Unit { int pm, pn, ko; };
struct Gemm { const bf16_t* A; const bf16_t* Bt; int lda, ldb, K; };
struct StaticOrder {
    int nM, nN, nwg, G, c;
    __device__ void init(int nM_, int nN_, int G_, int c_) { nM = nM_; nN = nN_; nwg = nM * nN; G = G_; c = c_; }
    __device__ bool next(int i, Unit& u) const {
        const long L = (long)i * G + c; if (L >= nwg) return false;
        int wgid = (int)L; { const int q = nwg / NXCD, r = nwg % NXCD, xcd = wgid % NXCD, off = wgid / NXCD; wgid = (xcd < r ? xcd * (q + 1) : r * (q + 1) + (xcd - r) * q) + off; }
        const int nig = WGM * nN, gid = wgid / nig, fm = gid * WGM, gsz = (nM - fm) < WGM ? (nM - fm) : WGM;
        u.pm = fm + ((wgid % nig) % gsz); u.pn = (wgid % nig) / gsz; u.ko = 0; return true;
    }
};
struct SplitOrder {
    int nN, S, Kc, G, c;
    __device__ bool next(int i, Unit& u) const { const long L = (long)i * G + c; if (L >= (long)nN * S) return false; u.pm = 64; u.pn = (int)(L % nN); u.ko = (int)(L / nN) * Kc; return true; }
};
struct DiagOrder {
    int n, G, c;
    __device__ bool next(int i, Unit& u) const { const long L = (long)i * G + c; if (L >= n) return false; u.pm = (int)L; u.pn = (int)(L >> 2); u.ko = 0; return true; }
};

typedef f32x4 AccT[2][2][4][2];

template <class Epi, class Sched>
__device__ __forceinline__ void gemm_phase_acc(LAS unsigned char* lds, const Gemm g, const Sched& S, const Epi& E, AccT& acc, const bool zero) {
    int tid_ = threadIdx.x; asm volatile("" : "+v"(tid_));
    const int tid = tid_, wid = __builtin_amdgcn_readfirstlane(tid >> 6), lane = tid & 63, wr = wid >> 2, wc = wid & 3, fr = lane & 15, fq = lane >> 4;
    const int nt = g.K / BK;
    unsigned voffA[2], voffB[2];
#pragma unroll
    for (int i = 0; i < 2; ++i) { int R, C; stage_rc(tid * 16 + i * 8192, R, C); const int Rb = Epi::PERM ? ((R & ~31) + perm32(R & 31)) : R;
        voffA[i] = (unsigned)(R * g.lda + C) * 2u; voffB[i] = (unsigned)(Rb * g.ldb + C) * 2u; }
    const size_t kstep = (size_t)(BK * 2);
    const size_t hstepA = (size_t)HALF * g.lda * 2, hstepB = (size_t)HALF * g.ldb * 2;
    const size_t tstepA = 2 * hstepA, tstepB = 2 * hstepB;
    const unsigned ldsw = (unsigned)wid * 1024u;
    const int aoff = lds_byte(wr * 64 + fr, fq * 8), boff = lds_byte(wc * 32 + fr, fq * 8);
#define PG8_SA(b, h) (((b) * 2 + (h)) * HTB)
#define PG8_SB(b, h) ((4 + (b) * 2 + (h)) * HTB)
#define PG8_STAGE(bufoff, gbase, voff) do { _Pragma("unroll") for (int _i = 0; _i < 2; ++_i) \
        __builtin_amdgcn_global_load_lds((const unsigned*)((const char*)(gbase) + (voff)[_i]), (LAS unsigned*)(lds + (bufoff) + ldsw + _i * 8192), 16, 0, 0); } while (0)
#define PG8_LDA(dst, b, h) do { _Pragma("unroll") for (int m = 0; m < 4; ++m) _Pragma("unroll") for (int k = 0; k < 2; ++k) dst[m][k] = *(const LAS bf16x8*)(lds + PG8_SA(b, h) + aoff + m * 2048 + k * 1024); } while (0)
#define PG8_LDB(dst, b, h) do { _Pragma("unroll") for (int n = 0; n < 2; ++n) _Pragma("unroll") for (int k = 0; k < 2; ++k) dst[n][k] = *(const LAS bf16x8*)(lds + PG8_SB(b, h) + boff + n * 2048 + k * 1024); } while (0)
#define PG8_MMA(ai, bj, At, Bt) do { __builtin_amdgcn_s_setprio(1); _Pragma("unroll") for (int m = 0; m < 4; ++m) _Pragma("unroll") for (int n = 0; n < 2; ++n) _Pragma("unroll") for (int k = 0; k < 2; ++k) \
        acc[ai][bj][m][n] = __builtin_amdgcn_mfma_f32_16x16x32_bf16(Bt[n][k], At[m][k], acc[ai][bj][m][n], 0, 0, 0); __builtin_amdgcn_s_setprio(0); } while (0)
#define PG8_WAIT_V(n) asm volatile("s_waitcnt vmcnt(" #n ")" ::: "memory")
#define PG8_WAIT_L(n) asm volatile("s_waitcnt lgkmcnt(" #n ")" ::: "memory")
#define PG8_BAR __builtin_amdgcn_s_barrier()
#define PG8_SCHED __builtin_amdgcn_sched_barrier(0)
    Unit cur, nxt; int ui = 0;
    if (!S.next(0, cur)) return;
    if (zero) {
#pragma unroll
    for (int a = 0; a < 2; ++a)
#pragma unroll
        for (int b = 0; b < 2; ++b)
#pragma unroll
            for (int m = 0; m < 4; ++m)
#pragma unroll
                for (int n = 0; n < 2; ++n) acc[a][b][m][n] = (f32x4){0.f, 0.f, 0.f, 0.f};
    }
    bf16x8 At[4][2], B0[2][2], B1[2][2];
    const char* cA = (const char*)g.A + (size_t)cur.pm * tstepA + (size_t)cur.ko * 2; const char* cB = (const char*)g.Bt + (size_t)cur.pn * tstepB + (size_t)cur.ko * 2;
    PG8_STAGE(PG8_SB(0, 0), cB, voffB); PG8_STAGE(PG8_SA(0, 0), cA, voffA); PG8_STAGE(PG8_SB(0, 1), cB + hstepB, voffB); PG8_STAGE(PG8_SA(0, 1), cA + hstepA, voffA);
    if (wr == 1) PG8_BAR;
    PG8_WAIT_V(4); PG8_BAR;
    PG8_STAGE(PG8_SB(1, 0), cB + kstep, voffB); PG8_STAGE(PG8_SA(1, 0), cA + kstep, voffA); PG8_STAGE(PG8_SB(1, 1), cB + hstepB + kstep, voffB);
    PG8_WAIT_V(6); PG8_BAR;
#pragma nounroll
    for (;;) {
        const bool has_next = S.next(ui + 1, nxt);
        const char* nA = has_next ? (const char*)g.A + (size_t)nxt.pm * tstepA + (size_t)nxt.ko * 2 : cA; const char* nB = has_next ? (const char*)g.Bt + (size_t)nxt.pn * tstepB + (size_t)nxt.ko * 2 : cB;
#pragma nounroll
        for (int t = 0; t < nt; t += 2) {
            const bool last = (t == nt - 2);
            const char* a1 = cA + (size_t)(t + 1) * kstep;
            const char* a2 = last ? nA : cA + (size_t)(t + 2) * kstep; const char* b2 = last ? nB : cB + (size_t)(t + 2) * kstep;
            const char* a3 = a2 + kstep; const char* b3 = b2 + kstep;
            PG8_LDB(B0, 0, 0); PG8_SCHED; PG8_LDA(At, 0, 0); PG8_STAGE(PG8_SA(1, 1), a1 + hstepA, voffA);
            PG8_WAIT_L(8); PG8_BAR; PG8_WAIT_L(0); PG8_MMA(0, 0, At, B0); PG8_BAR; PG8_SCHED;
            PG8_LDB(B1, 0, 1); PG8_STAGE(PG8_SB(0, 0), b2, voffB);
            PG8_BAR; PG8_WAIT_L(0); PG8_MMA(0, 1, At, B1); PG8_BAR;
            PG8_LDA(At, 0, 1); PG8_STAGE(PG8_SA(0, 0), a2, voffA);
            PG8_BAR; PG8_WAIT_L(0); PG8_MMA(1, 0, At, B0); PG8_BAR; PG8_SCHED;
            PG8_STAGE(PG8_SB(0, 1), b2 + hstepB, voffB);
            PG8_WAIT_V(6); PG8_BAR; PG8_MMA(1, 1, At, B1); PG8_BAR;
            PG8_LDB(B0, 1, 0); PG8_SCHED; PG8_LDA(At, 1, 0); PG8_STAGE(PG8_SA(0, 1), a2 + hstepA, voffA);
            PG8_WAIT_L(8); PG8_BAR; PG8_WAIT_L(0); PG8_MMA(0, 0, At, B0); PG8_BAR; PG8_SCHED;
            PG8_LDB(B1, 1, 1); PG8_STAGE(PG8_SB(1, 0), b3, voffB);
            PG8_BAR; PG8_WAIT_L(0); PG8_MMA(0, 1, At, B1); PG8_BAR;
            PG8_LDA(At, 1, 1); PG8_STAGE(PG8_SA(1, 0), a3, voffA);
            PG8_BAR; PG8_WAIT_L(0); PG8_MMA(1, 0, At, B0); PG8_BAR; PG8_SCHED;
            PG8_STAGE(PG8_SB(1, 1), b3 + hstepB, voffB);
            PG8_WAIT_V(6); PG8_BAR; PG8_MMA(1, 1, At, B1); PG8_BAR;
        }
        if constexpr (!Epi::AFTER_DRAIN) E(acc, cur, wr, wc, fr, fq);
        if (!has_next) break;
#pragma unroll
        for (int a = 0; a < 2; ++a)
#pragma unroll
            for (int b = 0; b < 2; ++b)
#pragma unroll
                for (int m = 0; m < 4; ++m)
#pragma unroll
                    for (int n = 0; n < 2; ++n) acc[a][b][m][n] = (f32x4){0.f, 0.f, 0.f, 0.f};
        cur = nxt; cA = nA; cB = nB; ++ui;
    }
    PG8_WAIT_V(0);
    if (wr == 0) PG8_BAR;
    PG8_BAR;
    if constexpr (Epi::AFTER_DRAIN) E.fused(acc, cur, wr, wc, fr, fq, lds, wid, lane);
#undef PG8_SA
#undef PG8_SB
#undef PG8_STAGE
#undef PG8_LDA
#undef PG8_LDB
#undef PG8_MMA
#undef PG8_WAIT_V
#undef PG8_WAIT_L
#undef PG8_BAR
#undef PG8_SCHED
}
template <class Epi, class Sched>
__device__ __forceinline__ void gemm_phase(LAS unsigned char* lds, const Gemm g, const Sched& S, const Epi& E) { AccT acc; gemm_phase_acc(lds, g, S, E, acc, true); }

#define EPI_ROWS_BEGIN  _Pragma("unroll") for (int ai = 0; ai < 2; ++ai) { if (u.pm * BM + ai * HALF >= MV) continue; _Pragma("unroll") for (int m = 0; m < 4; ++m) { const int row = u.pm * BM + ai * HALF + wr * 64 + m * 16 + fr;
#define EPI_ROWS_END    asm volatile("" ::: "memory"); } }

struct EpiFfnUp {
    static constexpr bool PERM = true, AFTER_DRAIN = false;
    bf16_t* H; const float* rs; int is_ss;
    __device__ __forceinline__ void operator()(const AccT& acc, const Unit& u, int wr, int wc, int fr, int fq) const {
        const int j0 = u.pn * 128 + wc * 32 + 8 * fq;
        EPI_ROWS_BEGIN
            const float s = is_ss ? row_rs(rs, row) : rs[row];
            f32x4 h0, h1;
#pragma unroll
            for (int j = 0; j < 4; ++j) { h0[j] = siluf_(acc[ai][0][m][0][j] * s) * (acc[ai][1][m][0][j] * s); h1[j] = siluf_(acc[ai][0][m][1][j] * s) * (acc[ai][1][m][1][j] * s); }
            store8(H + (size_t)row * FF + j0, h0, h1);
        EPI_ROWS_END
    }
};
struct EpiResid {
    static constexpr bool PERM = false, AFTER_DRAIN = false;
    const bf16_t* xb; bf16_t* XH; float* SS; float alpha; int first;
    __device__ __forceinline__ void operator()(const AccT& acc, const Unit& u, int wr, int wc, int fr, int fq) const {
        const int col0 = u.pn * BM + wc * 32 + 4 * fq;
        EPI_ROWS_BEGIN
            const bf16_t* src = xb + (size_t)row * DM;
            bf16_t* xr = XH + (size_t)row * 2048 + 1024; float ssq = 0.f;
#pragma unroll
            for (int bj = 0; bj < 2; ++bj)
#pragma unroll
                for (int n = 0; n < 2; ++n) { const int c = col0 + bj * HALF + n * 16; const f32x4 b = load4bf(first ? src + c : xr + c); const f32x4 o = b + acc[ai][bj][m][n] * alpha;
                    store4bf(xr + c, o); ssq += (o[0] * o[0] + o[1] * o[1]) + (o[2] * o[2] + o[3] * o[3]); }
            ssq += __shfl_xor(ssq, 16); ssq += __shfl_xor(ssq, 32);
            if (fq == 0) SS[(size_t)row * 16 + u.pn * 4 + wc] = ssq;
        EPI_ROWS_END
    }
};
struct EpiWin {
    static constexpr bool PERM = true, AFTER_DRAIN = false;
    const float* SS; bf16_t* F; bf16_t* As5; float* Us; bf16_t* Gt;
    __device__ __forceinline__ void operator()(const AccT& acc, const Unit& u, int wr, int wc, int fr, int fq) const {
        const int c0b = u.pn * BM + wc * 32 + 8 * fq;
        EPI_ROWS_BEGIN
            const float s = row_rs(SS, row);
#pragma unroll
            for (int bj = 0; bj < 2; ++bj) { const int c0 = c0b + bj * HALF; f32x4 v0 = acc[ai][bj][m][0] * s, v1 = acc[ai][bj][m][1] * s;
                if (u.pn < 7) store8(F + (size_t)row * RC + c0, v0, v1);
                else if (u.pn < 9) { const int uc = c0 - RC;
                    if (row < MPROMPT) { const int g = uc >> 4, h0 = uc & 15, b = row >> 11, t = row & 2047, c = t >> 4, tl = t & 15;
                        store8(As5 + ((size_t)(g * 1024 + b * 128 + c)) * 384 + 128 + tl * 16 + h0, v0, v1); }
                    else { float* d = Us + (size_t)(row - MPROMPT) * 512 + uc; *(f32x4*)d = v0; *(f32x4*)(d + 4) = v1; } }
                else { const int gc = c0 - 2304;
#pragma unroll
                    for (int j = 0; j < 4; ++j) { v0[j] = sigmoidf_(v0[j]); v1[j] = sigmoidf_(v1[j]); }
                    store8(Gt + (size_t)row * 2048 + gc, v0, v1); } }
        EPI_ROWS_END
    }
};
struct EpiLora {
    static constexpr bool PERM = true, AFTER_DRAIN = false;
    bf16_t* LOwa; bf16_t* LOg;
    __device__ __forceinline__ void operator()(const AccT& acc, const Unit& u, int wr, int wc, int fr, int fq) const {
        const int c0b = u.pn * BM + wc * 32 + 8 * fq;
        EPI_ROWS_BEGIN
#pragma unroll
            for (int bj = 0; bj < 2; ++bj) { const int c0 = c0b + bj * HALF;
                if (u.pn < 4) store8(LOwa + (size_t)row * 1024 + c0, acc[ai][bj][m][0], acc[ai][bj][m][1]);
                else store8(LOg + (size_t)row * 512 + c0 - 1024, acc[ai][bj][m][0], acc[ai][bj][m][1]); }
        EPI_ROWS_END
    }
};
struct EpiS5a {
    static constexpr bool PERM = false, AFTER_DRAIN = false;
    float* E;
    __device__ __forceinline__ void operator()(const AccT& acc, const Unit& u, int wr, int wc, int fr, int fq) const {
        const int g = u.pn, n0 = wc * 32 + 4 * fq;
#pragma unroll
        for (int ai = 0; ai < 2; ++ai)
#pragma unroll
            for (int m = 0; m < 4; ++m) { const int mr = (u.pm & 3) * 256 + ai * HALF + wr * 64 + m * 16 + fr;
#pragma unroll
                for (int n = 0; n < 2; ++n) *(f32x4*)(E + ((size_t)(g * 1024 + mr)) * 128 + n0 + n * 16) = acc[ai][0][m][n]; }
    }
};
struct EpiS5b {
    static constexpr bool PERM = true, AFTER_DRAIN = false;
    const bf16_t* As5; const float* Dsk; bf16_t* Z;
    __device__ __forceinline__ void operator()(const AccT& acc, const Unit& u, int wr, int wc, int fr, int fq) const {
        const int g = u.pn;
#pragma unroll
        for (int ai = 0; ai < 2; ++ai)
#pragma unroll
            for (int m = 0; m < 4; ++m) { const int mr = (u.pm & 3) * 256 + ai * HALF + wr * 64 + m * 16 + fr; const int b = mr >> 7, c = mr & 127;
#pragma unroll
                for (int bj = 0; bj < 2; ++bj) { const int n0 = bj * HALF + wc * 32 + 8 * fq, tl = n0 >> 4, h0 = n0 & 15; const int col = g * 16 + h0;
                    f32x4 u0, u1; load8(As5 + ((size_t)(g * 1024 + mr)) * 384 + 128 + n0, u0, u1);
                    const f32x4 d0 = *(const f32x4*)(Dsk + col), d1 = *(const f32x4*)(Dsk + col + 4);
                    f32x4 y0 = acc[ai][bj][m][0] + d0 * u0, y1 = acc[ai][bj][m][1] + d1 * u1;
#pragma unroll
                    for (int j = 0; j < 4; ++j) { y0[j] = geluf_(y0[j]); y1[j] = geluf_(y1[j]); }
                    store8(Z + ((size_t)(b * 2048 + c * 16 + tl)) * 512 + col, y0, y1); }
                asm volatile("" ::: "memory"); }
    }
};
struct EpiGlu {
    static constexpr bool PERM = true, AFTER_DRAIN = false;
    const bf16_t* Z; bf16_t* YAB;
    __device__ __forceinline__ void operator()(const AccT& acc, const Unit& u, int wr, int wc, int fr, int fq) const {
        const int c0b = u.pn * BM + wc * 32 + 8 * fq;
        EPI_ROWS_BEGIN
#pragma unroll
            for (int bj = 0; bj < 2; ++bj) { const int c0 = c0b + bj * HALF; f32x4 z0, z1; load8(Z + (size_t)row * 512 + c0, z0, z1);
                f32x4 v0 = acc[ai][bj][m][0], v1 = acc[ai][bj][m][1];
#pragma unroll
                for (int j = 0; j < 4; ++j) { v0[j] = z0[j] * sigmoidf_(v0[j]); v1[j] = z1[j] * sigmoidf_(v1[j]); }
                store8(YAB + (size_t)row * 1024 + 512 + c0, v0, v1); }
        EPI_ROWS_END
    }
};
struct EpiGateRatio {
    static constexpr bool PERM = true, AFTER_DRAIN = false;
    const bf16_t* Gt;
    __device__ __forceinline__ void operator()(AccT& acc, const Unit& u, int wr, int wc, int fr, int fq) const {
        const int c0b = u.pn * BM + wc * 32 + 8 * fq;
        EPI_ROWS_BEGIN
#pragma unroll
            for (int bj = 0; bj < 2; ++bj) { const int c0 = c0b + bj * HALF; f32x4 a0, a1, b0, b1; load8(Gt + (size_t)row * 2048 + c0, a0, a1); load8(Gt + (size_t)row * 2048 + 1024 + c0, b0, b1);
#pragma unroll
                for (int j = 0; j < 4; ++j) { acc[ai][bj][m][0][j] *= a0[j] * __builtin_amdgcn_rcpf(fmaxf(b0[j], 1e-30f)); acc[ai][bj][m][1][j] *= a1[j] * __builtin_amdgcn_rcpf(fmaxf(b1[j], 1e-30f)); } }
        EPI_ROWS_END
    }
};
struct EpiGateOut {
    static constexpr bool PERM = true, AFTER_DRAIN = false;
    const bf16_t* Gt; bf16_t* Mg;
    __device__ __forceinline__ void operator()(const AccT& acc, const Unit& u, int wr, int wc, int fr, int fq) const {
        const int c0b = u.pn * BM + wc * 32 + 8 * fq;
        EPI_ROWS_BEGIN
#pragma unroll
            for (int bj = 0; bj < 2; ++bj) { const int c0 = c0b + bj * HALF; f32x4 b0, b1; load8(Gt + (size_t)row * 2048 + 1024 + c0, b0, b1);
                store8(Mg + (size_t)row * 1024 + c0, acc[ai][bj][m][0] * b0, acc[ai][bj][m][1] * b1); }
        EPI_ROWS_END
    }
};
struct EpiGate {
    static constexpr bool PERM = true, AFTER_DRAIN = false;
    const bf16_t* Gt; bf16_t* T; bf16_t* Mg; int second;
    __device__ __forceinline__ void operator()(const AccT& acc, const Unit& u, int wr, int wc, int fr, int fq) const {
        const int c0b = u.pn * BM + wc * 32 + 8 * fq;
        EPI_ROWS_BEGIN
#pragma unroll
            for (int bj = 0; bj < 2; ++bj) { const int c0 = c0b + bj * HALF; f32x4 g0, g1; load8(Gt + (size_t)row * 2048 + (second ? 1024 : 0) + c0, g0, g1);
                f32x4 v0 = acc[ai][bj][m][0] * g0, v1 = acc[ai][bj][m][1] * g1;
                if (second) { f32x4 t0, t1; load8(T + (size_t)row * 1024 + c0, t0, t1); v0 += t0; v1 += t1; store8(Mg + (size_t)row * 1024 + c0, v0, v1); }
                else store8(T + (size_t)row * 1024 + c0, v0, v1); }
        EPI_ROWS_END
    }
};

struct EpiFinal {
    static constexpr bool PERM = false, AFTER_DRAIN = true;
    float* X; const float* gfin; float* slots; unsigned* pcnt;
    __device__ __forceinline__ void fused(AccT& acc, const Unit& u, int wr, int wc, int fr, int fq, LAS unsigned char* lds, int wid, int lane) const {
        LAS float* Pp = (LAS float*)lds;
        LAS float* Sr = (LAS float*)(lds + 4096);
        const int col0 = u.pn * BM + wc * 32 + 4 * fq, tid = threadIdx.x;
#pragma unroll
        for (int ai = 0; ai < 2; ++ai)
#pragma unroll
            for (int m = 0; m < 4; ++m) { const int rl = ai * HALF + wr * 64 + m * 16 + fr; const bf16_t* src = (const bf16_t*)X + (size_t)(u.pm * BM + rl) * 2048 + 1024 + col0; float ssq = 0.f;
#pragma unroll
                for (int bj = 0; bj < 2; ++bj)
#pragma unroll
                    for (int n = 0; n < 2; ++n) { const f32x4 o = load4bf(src + bj * HALF + n * 16) + acc[ai][bj][m][n] * 0.5f; acc[ai][bj][m][n] = o; ssq += (o[0] * o[0] + o[1] * o[1]) + (o[2] * o[2] + o[3] * o[3]); }
                ssq += __shfl_xor(ssq, 16); ssq += __shfl_xor(ssq, 32);
                if (fq == 0) Pp[rl * 4 + wc] = ssq;
                asm volatile("" ::: "memory"); }
        __syncthreads();
        if (tid < 256) { const float sblk = (Pp[tid * 4] + Pp[tid * 4 + 1]) + (Pp[tid * 4 + 2] + Pp[tid * 4 + 3]);
            __hip_atomic_store(slots + ((size_t)(u.pm * BM + tid)) * 4 + u.pn, sblk, __ATOMIC_RELAXED, __HIP_MEMORY_SCOPE_AGENT); }
        asm volatile("s_waitcnt vmcnt(0)" ::: "memory");
        __syncthreads();
        if (tid == 0) { __hip_atomic_fetch_add(pcnt + 64 * u.pm, 1u, __ATOMIC_RELAXED, __HIP_MEMORY_SCOPE_AGENT);
            unsigned spins = 0; while (__hip_atomic_load(pcnt + 64 * u.pm, __ATOMIC_RELAXED, __HIP_MEMORY_SCOPE_AGENT) < 4u && ++spins < (1u << 22)) __builtin_amdgcn_s_sleep(2);
            __builtin_amdgcn_fence(__ATOMIC_ACQUIRE, "agent"); asm volatile("s_waitcnt vmcnt(0)" ::: "memory"); }
        __syncthreads();
        if (tid < 256) { const float* sl = slots + ((size_t)(u.pm * BM + tid)) * 4; float t = 0.f;
#pragma unroll
            for (int k = 0; k < 4; ++k) t += __hip_atomic_load(sl + k, __ATOMIC_RELAXED, __HIP_MEMORY_SCOPE_AGENT);
            Sr[tid] = rsqrtf(t * (1.0f / 1024.0f) + 1e-6f); }
        __syncthreads();
#pragma unroll
        for (int ai = 0; ai < 2; ++ai)
#pragma unroll
            for (int m = 0; m < 4; ++m) { const int rl = ai * HALF + wr * 64 + m * 16 + fr; const float sc = Sr[rl]; float* dst = X + (size_t)(u.pm * BM + rl) * DM + col0;
#pragma unroll
                for (int bj = 0; bj < 2; ++bj)
#pragma unroll
                    for (int n = 0; n < 2; ++n) { const f32x4 gf = *(const f32x4*)(gfin + col0 + bj * HALF + n * 16); *(f32x4*)(dst + bj * HALF + n * 16) = acc[ai][bj][m][n] * sc * gf; }
                asm volatile("" ::: "memory"); }
        __syncthreads();
    }
};
struct EpiSlabGate {
    static constexpr bool PERM = false, AFTER_DRAIN = true;
    unsigned char* ws; int base16;
    __device__ __forceinline__ void fused(AccT& acc, const Unit& u, int wr, int wc, int fr, int fq, LAS unsigned char* lds, int wid, int lane) const {
        float* slab = (float*)(ws + WS_SLAB); unsigned* cnt = (unsigned*)(ws + WS_PCNT) + 4081; const bf16_t* Gt = (const bf16_t*)(ws + WS_RG); bf16_t* Mg = (bf16_t*)(ws + WS_RH + RH_MG);
        const int col0 = u.pn * BM + wc * 32 + 4 * fq, slice = u.ko / 256, tid = threadIdx.x;
        float* myslab = slab + (base16 ? (size_t)256 * 1024 : 0);
#pragma unroll
        for (int m = 0; m < 4; ++m) { float* d = myslab + ((size_t)(slice * 128 + wr * 64 + m * 16 + fr)) * 1024 + col0;
#pragma unroll
            for (int bj = 0; bj < 2; ++bj)
#pragma unroll
                for (int n = 0; n < 2; ++n) *(f32x4*)(d + bj * HALF + n * 16) = acc[0][bj][m][n]; }
        asm volatile("s_waitcnt vmcnt(0)" ::: "memory");
        __syncthreads();
        if (tid == 0) { __builtin_amdgcn_fence(__ATOMIC_RELEASE, "agent"); asm volatile("s_waitcnt vmcnt(0)" ::: "memory");
            __hip_atomic_fetch_add(cnt, 1u, __ATOMIC_RELAXED, __HIP_MEMORY_SCOPE_AGENT);
            unsigned spins = 0; while (__hip_atomic_load(cnt, __ATOMIC_RELAXED, __HIP_MEMORY_SCOPE_AGENT) < 16u && ++spins < (1u << 22)) __builtin_amdgcn_s_sleep(2);
            __builtin_amdgcn_fence(__ATOMIC_ACQUIRE, "agent"); asm volatile("s_waitcnt vmcnt(0)" ::: "memory"); }
        __syncthreads();
        const int r = (base16 + slice * 4 + u.pn) * 8 + wid; const size_t row = (size_t)MPROMPT + r;
#pragma unroll
        for (int i = 0; i < 4; ++i) { const int c = i * 256 + lane * 4;
            const f32x4 pa = *(const f32x4*)(slab + (size_t)r * 1024 + c) + *(const f32x4*)(slab + (size_t)(128 + r) * 1024 + c);
            const f32x4 pb = *(const f32x4*)(slab + (size_t)(256 + r) * 1024 + c) + *(const f32x4*)(slab + (size_t)(384 + r) * 1024 + c);
            const f32x4 ga = load4bf(Gt + row * 2048 + c), gb = load4bf(Gt + row * 2048 + 1024 + c);
            store4bf(Mg + row * 1024 + c, ga * pa + gb * pb); }
    }
};
struct EpiSlab {
    static constexpr bool PERM = false, AFTER_DRAIN = false;
    float* slab; int Kc;
    __device__ __forceinline__ void operator()(const AccT& acc, const Unit& u, int wr, int wc, int fr, int fq) const {
        const int col0 = u.pn * BM + wc * 32 + 4 * fq, slice = u.ko / Kc;
        EPI_ROWS_BEGIN
            float* d = slab + ((size_t)(slice * 128 + (row - MPROMPT))) * 1024 + col0;
#pragma unroll
            for (int bj = 0; bj < 2; ++bj)
#pragma unroll
                for (int n = 0; n < 2; ++n) *(f32x4*)(d + bj * HALF + n * 16) = acc[ai][bj][m][n];
        EPI_ROWS_END
    }
};

__device__ __forceinline__ void conv_matrix(LAS float* tile, const float* src, int K, int N, bf16_t* dst, int ldd, int nmul, int nadd, const float* scale, int bi, int nb) {
    const int t = threadIdx.x, tk = K >> 6, tn = N >> 6, nt = tk * tn;
    const int kr = t >> 3, nc = (t & 7) * 8;
    for (int id0 = bi; id0 < nt; id0 += 4 * nb) {
        f32x4 a[4], b[4]; float sc[4];
#pragma unroll
        for (int q = 0; q < 4; ++q) { const int id = id0 + q * nb;
            if (id < nt) { const int k0 = (id / tn) << 6, n0 = (id % tn) << 6; const float* sp = src + (size_t)(k0 + kr) * N + n0 + nc; a[q] = *(const f32x4*)sp; b[q] = *(const f32x4*)(sp + 4); sc[q] = scale ? scale[k0 + kr] : 1.0f; }
            else { a[q] = (f32x4){0.f, 0.f, 0.f, 0.f}; b[q] = a[q]; sc[q] = 0.f; } }
#pragma unroll
        for (int q = 0; q < 4; ++q) { LAS float* tq = tile + q * (64 * 65);
#pragma unroll
            for (int i = 0; i < 4; ++i) { tq[kr * 65 + nc + i] = a[q][i] * sc[q]; tq[kr * 65 + nc + 4 + i] = b[q][i] * sc[q]; } }
        __syncthreads();
#pragma unroll
        for (int q = 0; q < 4; ++q) { const int id = id0 + q * nb;
            if (id < nt) { const int k0 = (id / tn) << 6, n0 = (id % tn) << 6; const LAS float* tq = tile + q * (64 * 65); const int nr = t >> 3, kc = (t & 7) * 8; f32x4 x, y;
#pragma unroll
                for (int i = 0; i < 4; ++i) { x[i] = tq[(kc + i) * 65 + nr]; y[i] = tq[(kc + 4 + i) * 65 + nr]; }
                const int nn = n0 + nr; const int drow = nmul == 2 ? (((nn >> 7) << 8) + (nn & 127) + nadd * 128) : nn;
                store8(dst + (size_t)drow * ldd + k0 + kc, x, y); } }
        __syncthreads();
    }
}

__device__ __forceinline__ void conv_job(const Params& P, LAS float* tile, int j, int bi, int nb) {
    unsigned char* ws = P.ws; const float* src; const float* scale = nullptr; int K, N, ldd, nmul = 1, nadd = 0; bf16_t* dst;
    switch (j) {
        case 0: src = P.in[7]; K = 1024; N = FF; dst = (bf16_t*)(ws + WS_WFFN); ldd = 1024; nmul = 2; scale = P.in[6]; break;
        case 1: src = P.in[8]; K = 1024; N = FF; dst = (bf16_t*)(ws + WS_WFFN); ldd = 1024; nmul = 2; nadd = 1; scale = P.in[6]; break;
        case 2: src = P.in[9]; K = FF; N = 1024; dst = (bf16_t*)(ws + WS_WDT); ldd = FF; break;
        case 3: src = P.in[11]; K = 1024; N = 4352; dst = (bf16_t*)(ws + WS_WIN); ldd = 1024; scale = P.in[10]; break;
        case 4: src = P.in[31]; K = 512; N = 512; dst = (bf16_t*)(ws + WS_WGLU); ldd = 512; break;
        case 5: src = P.in[32]; K = 512; N = 1024; dst = (bf16_t*)(ws + WS_WA); ldd = 512; break;
        case 6: src = P.in[33]; K = 512; N = 1024; dst = (bf16_t*)(ws + WS_WB); ldd = 512; break;
        case 7: src = P.in[34]; K = 1024; N = 1024; dst = (bf16_t*)(ws + WS_WOUT); ldd = 1024; break;
        case 8: src = P.in[36]; K = 1024; N = FF; dst = (bf16_t*)(ws + WS_WFFN); ldd = 1024; nmul = 2; scale = P.in[35]; break;
        case 9: src = P.in[37]; K = 1024; N = FF; dst = (bf16_t*)(ws + WS_WFFN); ldd = 1024; nmul = 2; nadd = 1; scale = P.in[35]; break;
        default: src = P.in[38]; K = FF; N = 1024; dst = (bf16_t*)(ws + WS_WDT); ldd = FF; break;
    }
    conv_matrix(tile, src, K, N, dst, ldd, nmul, nadd, scale, bi, nb);
}

__device__ __forceinline__ void s5_pow(float lr, float li, float dt, float j, float& ar, float& ai) { const float mg = __expf(lr * dt * j), ang = li * dt * j; ar = mg * cosf(ang); ai = mg * sinf(ang); }
__device__ __forceinline__ void s5_q(float lr, float li, float dt, float& qr, float& qi) { float ar, ai; s5_pow(lr, li, dt, 1.0f, ar, ai); const float den = lr * lr + li * li; qr = ((ar - 1.0f) * lr + ai * li) / den; qi = (ai * lr - (ar - 1.0f) * li) / den; }

__device__ __forceinline__ void phase_prep(const Params& P, LAS unsigned char* lds) {
    unsigned char* ws = P.ws; const int tid = threadIdx.x, lane = tid & 63, wave = tid >> 6;
    const size_t gtid = (size_t)blockIdx.x * NTHR + tid, gthreads = (size_t)gridDim.x * NTHR;
    { bf16_t* xb = (bf16_t*)(ws + WS_RX); float* rs1 = (float*)(ws + WS_RS1);
      for (int row0 = blockIdx.x * 8 + wave; row0 < MP; row0 += 2 * gridDim.x * 8) {
          f32x4 v[2][4];
#pragma unroll
          for (int q = 0; q < 2; ++q) { const int row = row0 + q * gridDim.x * 8;
              if (row < MV) { const float* src = row < MPROMPT ? P.in[0] + (size_t)row * DM : P.in[1] + (size_t)(row - MPROMPT) * DM;
#pragma unroll
                  for (int i = 0; i < 4; ++i) v[q][i] = *(const f32x4*)(src + i * 256 + lane * 4); }
              else {
#pragma unroll
                  for (int i = 0; i < 4; ++i) v[q][i] = (f32x4){0.f, 0.f, 0.f, 0.f}; } }
#pragma unroll
          for (int q = 0; q < 2; ++q) { const int row = row0 + q * gridDim.x * 8; if (row >= MP) continue; float ssq = 0.f;
#pragma unroll
              for (int i = 0; i < 4; ++i) { ssq += (v[q][i][0] * v[q][i][0] + v[q][i][1] * v[q][i][1]) + (v[q][i][2] * v[q][i][2] + v[q][i][3] * v[q][i][3]); store4bf(xb + (size_t)row * DM + i * 256 + lane * 4, v[q][i]); }
              ssq = red64(ssq);
              if (lane == 0) rs1[row] = row < MV ? rsqrtf(ssq * (1.0f / 1024.0f) + 1e-6f) : 0.f; } } }
    LAS float* tile = (LAS float*)lds;
    for (int j = 0; j < 3; ++j) conv_job(P, tile, j, blockIdx.x, gridDim.x);
}

__device__ __forceinline__ void phase_prep2(const Params& P, LAS unsigned char* lds, int blk_i, int blk_n) {
    unsigned char* ws = P.ws; const int tid = threadIdx.x, lane = tid & 63, wave = tid >> 6;
    const size_t gtid = (size_t)blk_i * NTHR + tid, gthreads = (size_t)blk_n * NTHR;
    LAS float* tile = (LAS float*)lds;
    { bf16_t* wl = (bf16_t*)(ws + WS_WL);
      for (size_t i = gtid; i < (size_t)1536 * 32; i += gthreads) { const int n = (int)(i >> 5), k0 = (int)(i & 31) * 8; f32x4 a = {0.f, 0.f, 0.f, 0.f}, b = a;
          if (n < 512) { if (k0 < 64) { for (int j = 0; j < 4; ++j) { a[j] = P.in[14][(size_t)(k0 + j) * 512 + n]; b[j] = P.in[14][(size_t)(k0 + 4 + j) * 512 + n]; } } }
          else if (n < 1024) { if (k0 >= 64 && k0 < 128) { for (int j = 0; j < 4; ++j) { a[j] = P.in[16][(size_t)(k0 - 64 + j) * 512 + n - 512]; b[j] = P.in[16][(size_t)(k0 - 60 + j) * 512 + n - 512]; } } }
          else { if (k0 >= 128) { for (int j = 0; j < 4; ++j) { a[j] = P.in[17][(size_t)(k0 - 128 + j) * 512 + n - 1024]; b[j] = P.in[17][(size_t)(k0 - 124 + j) * 512 + n - 1024]; } } }
          store8(wl + (size_t)n * 256 + k0, a, b); } }
    const float* Are = P.in[23]; const float* Aim = P.in[24]; const float* ldt = P.in[25]; const float* Bre = P.in[26]; const float* Bim = P.in[27]; const float* Cre = P.in[28]; const float* Cim = P.in[29];
    { float* abar = (float*)(ws + WS_ABAR); float* abar16 = (float*)(ws + WS_ABAR16); float* bbt = (float*)(ws + WS_BBT);
      for (size_t i = gtid; i < 2048; i += gthreads) { const int g = (int)(i >> 6); const float dt = __expf(ldt[g]), lr = Are[i], li = Aim[i]; float ar, ai; s5_pow(lr, li, dt, 1.0f, ar, ai); abar[2 * i] = ar; abar[2 * i + 1] = ai;
          s5_pow(lr, li, dt, 16.0f, ar, ai); abar16[2 * i] = ar; abar16[2 * i + 1] = ai; float qr, qi; s5_q(lr, li, dt, qr, qi);
          for (int h = 0; h < 16; ++h) { const float br = Bre[i * 16 + h], bi = Bim[i * 16 + h]; bbt[(i * 16 + h) * 2] = qr * br - qi * bi; bbt[(i * 16 + h) * 2 + 1] = qr * bi + qi * br; } } }
    { bf16_t* w1 = (bf16_t*)(ws + WS_S5W1);
      for (size_t i = gtid; i < (size_t)32 * 128 * 16; i += gthreads) { const int s = (int)(i & 15), n = (int)((i >> 4) & 127), g = (int)(i >> 11); const int p = n & 63, im = n >> 6; const int gp = g * 64 + p;
          const float dt = __expf(ldt[g]), lr = Are[gp], li = Aim[gp]; float ar, ai, qr, qi; s5_pow(lr, li, dt, (float)(15 - s), ar, ai); s5_q(lr, li, dt, qr, qi);
          f32x4 o[4];
#pragma unroll
          for (int h = 0; h < 16; ++h) { const float br = Bre[gp * 16 + h], bi = Bim[gp * 16 + h]; const float bbr = qr * br - qi * bi, bbi = qr * bi + qi * br; o[h >> 2][h & 3] = im ? (ar * bbi + ai * bbr) : (ar * bbr - ai * bbi); }
          bf16_t* d = w1 + ((size_t)(g * 256 + n)) * 256 + s * 16; store8(d, o[0], o[1]); store8(d + 8, o[2], o[3]); }
      for (size_t i = gtid; i < (size_t)32 * 128 * 32; i += gthreads) { const int k8 = (int)(i & 31), n = 128 + (int)((i >> 5) & 127), g = (int)(i >> 12); *(u32x4*)(w1 + ((size_t)(g * 256 + n)) * 256 + k8 * 8) = (u32x4){0u, 0u, 0u, 0u}; } }
    { bf16_t* w2 = (bf16_t*)(ws + WS_S5W2);
      for (size_t i = gtid; i < (size_t)32 * 16 * 64; i += gthreads) { const int p = (int)(i & 63), tl = (int)((i >> 6) & 15), g = (int)(i >> 10); const int gp = g * 64 + p;
          const float dt = __expf(ldt[g]); float ar, ai; s5_pow(Are[gp], Aim[gp], dt, (float)(tl + 1), ar, ai);
          for (int h = 0; h < 16; ++h) { const float cr = Cre[(g * 16 + h) * 64 + p], ci = Cim[(g * 16 + h) * 64 + p]; bf16_t* d = w2 + ((size_t)(g * 256 + tl * 16 + h)) * 384;
              d[p] = (bf16_t)(cvt_pk_bf16(cr * ar - ci * ai, 0.f) & 0xffffu); d[64 + p] = (bf16_t)(cvt_pk_bf16(-cr * ai - ci * ar, 0.f) & 0xffffu); } } }
    { float* kt = (float*)(ws + WS_KT);
      for (int task = blk_i * 8 + wave; task < 32 * 16 * 16; task += blk_n * 8) { const int hp = task & 15, j = (task >> 4) & 15, g = task >> 8; const int gp = g * 64 + lane;
          const float dt = __expf(ldt[g]), lr = Are[gp], li = Aim[gp]; float ar, ai, qr, qi; s5_pow(lr, li, dt, (float)j, ar, ai); s5_q(lr, li, dt, qr, qi);
          const float br = Bre[gp * 16 + hp], bi = Bim[gp * 16 + hp]; const float bbr = qr * br - qi * bi, bbi = qr * bi + qi * br; const float xr = ar * bbr - ai * bbi, xi = ar * bbi + ai * bbr;
          float mine = 0.f;
          for (int h = 0; h < 16; ++h) { float v = Cre[(g * 16 + h) * 64 + lane] * xr - Cim[(g * 16 + h) * 64 + lane] * xi; v = red64(v); if (lane == h) mine = v; }
          if (lane < 16) kt[((g * 16 + j) * 16 + lane) * 16 + hp] = mine; } }
}

__device__ __forceinline__ void phase_mix(const Params& P) {
    unsigned char* ws = P.ws; const size_t gtid = (size_t)blockIdx.x * NTHR + threadIdx.x, gthreads = (size_t)gridDim.x * NTHR;
    const bf16_t* F = (const bf16_t*)(ws + WS_RH + RH_F); bf16_t* Lin = (bf16_t*)(ws + WS_RH + RH_LIN); const float* mu = P.in[12]; const float* sshift = P.in[2];
    for (size_t i = gtid; i < (size_t)MV * 32; i += gthreads) { const int row = (int)(i >> 5), ch = (int)(i & 31), col = 1536 + ch * 8;
        f32x4 f0, f1, p0, p1; load8(F + (size_t)row * RC + col, f0, f1);
        if (row < MPROMPT) { if ((row & 2047) > 0) load8(F + (size_t)(row - 1) * RC + col, p0, p1); else { p0 = (f32x4){0.f, 0.f, 0.f, 0.f}; p1 = p0; } }
        else { const float* s = sshift + (size_t)(row - MPROMPT) * RC + col; p0 = *(const f32x4*)s; p1 = *(const f32x4*)(s + 4); }
        const f32x4 m0 = *(const f32x4*)(mu + col), m1 = *(const f32x4*)(mu + col + 4);
        f0 = f0 + m0 * (p0 - f0); f1 = f1 + m1 * (p1 - f1);
        if (ch < 8) {
#pragma unroll
            for (int j = 0; j < 4; ++j) { f0[j] = tanhf_(f0[j]); f1[j] = tanhf_(f1[j]); } }
        else if (ch >= 16) {
#pragma unroll
            for (int j = 0; j < 4; ++j) { f0[j] = sigmoidf_(f0[j]); f1[j] = sigmoidf_(f1[j]); } }
        store8(Lin + (size_t)row * 256 + ch * 8, f0, f1); }
    for (size_t i = gtid; i < (size_t)136 * 224; i += gthreads) { const int r = (int)(i / 224), c8 = (int)(i % 224) * 8; const int row = r < 8 ? r * 2048 + 2047 : MPROMPT + (r - 8);
        f32x4 a, b; load8(F + (size_t)row * RC + c8, a, b); float* d = P.out + (r < 8 ? O_SHP + (size_t)r * RC : O_SHS + (size_t)(r - 8) * RC) + c8; *(f32x4*)d = a; *(f32x4*)(d + 4) = b; }
    { bf16_t* w2 = (bf16_t*)(ws + WS_S5W2); const float* kt = (const float*)(ws + WS_KT);
      for (size_t i = gtid; i < (size_t)32 * 256 * 32; i += gthreads) { const int k8 = (int)(i & 31), n = (int)((i >> 5) & 255), g = (int)(i >> 13); const int tl = n >> 4, h = n & 15, s = k8 >> 1, hp0 = (k8 & 1) * 8;
          f32x4 a = {0.f, 0.f, 0.f, 0.f}, b = a;
          if (s <= tl) { const float* src = kt + ((size_t)((g * 16 + (tl - s)) * 16 + h)) * 16 + hp0; a = *(const f32x4*)src; b = *(const f32x4*)(src + 4); }
          store8(w2 + ((size_t)(g * 256 + n)) * 384 + 128 + k8 * 8, a, b); } }
}

__device__ __forceinline__ void phase_carry(const Params& P, int b, int g, int p) {
    unsigned char* ws = P.ws;
    const float* E = P.out + O_WKVS; bf16_t* As5 = (bf16_t*)(ws + WS_RH + RH_AS5); const float* a16 = (const float*)(ws + WS_ABAR16);
    const float ar = a16[(g * 64 + p) * 2], ai = a16[(g * 64 + p) * 2 + 1];
    float xr = 0.f, xi = 0.f; const size_t base = (size_t)(g * 1024 + b * 128);
    for (int c0 = 0; c0 < 128; c0 += 32) {
        float er[32], ei[32];
#pragma unroll
        for (int j = 0; j < 32; ++j) { er[j] = E[(base + c0 + j) * 128 + p]; ei[j] = E[(base + c0 + j) * 128 + 64 + p]; }
#pragma unroll
        for (int j = 0; j < 32; ++j) { bf16_t* d = As5 + (base + c0 + j) * 384; d[p] = (bf16_t)(cvt_pk_bf16(xr, 0.f) & 0xffffu); d[64 + p] = (bf16_t)(cvt_pk_bf16(xi, 0.f) & 0xffffu);
            const float nr = ar * xr - ai * xi + er[j], ni = ar * xi + ai * xr + ei[j]; xr = nr; xi = ni; }
    }
    P.out[O_S5RP + (size_t)(b * 32 + g) * 64 + p] = xr; P.out[O_S5IP + (size_t)(b * 32 + g) * 64 + p] = xi;
}

constexpr int REC = 388;
struct PrepC { f32x4 mur, muk, muv, w0, a0, kk, ka, rk; };
__device__ __forceinline__ void load_prepc(PrepC& c, const Params& P, int h, int l16) { const int ch = h * 64 + l16 * 4;
    c.mur = *(const f32x4*)(P.in[12] + ch); c.muk = *(const f32x4*)(P.in[12] + 512 + ch); c.muv = *(const f32x4*)(P.in[12] + 1024 + ch);
    c.w0 = *(const f32x4*)(P.in[13] + ch); c.a0 = *(const f32x4*)(P.in[15] + ch); c.kk = *(const f32x4*)(P.in[18] + ch); c.ka = *(const f32x4*)(P.in[19] + ch); c.rk = *(const f32x4*)(P.in[20] + ch); }
__device__ __forceinline__ float prep_compute(const PrepC& c, f32x4 fr, f32x4 fk, f32x4 fv, f32x4 pr, f32x4 pk, f32x4 pv, f32x4 wpre, f32x4 apre, LAS float* rec, int l16) {
    const f32x4 r = fr + c.mur * (pr - fr), k = fk + c.muk * (pk - fk), v = fv + c.muv * (pv - fv);
    f32x4 w, a, kk, kp, b, wr;
#pragma unroll
    for (int i = 0; i < 4; ++i) { w[i] = __expf(-0.60653065971f * sigmoidf_(c.w0[i] + wpre[i])); a[i] = sigmoidf_(c.a0[i] + apre[i]); kk[i] = k[i] * c.kk[i]; }
    float n2 = (kk[0] * kk[0] + kk[1] * kk[1]) + (kk[2] * kk[2] + kk[3] * kk[3]); n2 = red16(n2);
    const float inv = 1.0f / fmaxf(sqrtf(n2), 1e-12f);
    float br = 0.f, kr = 0.f, bon = 0.f;
#pragma unroll
    for (int i = 0; i < 4; ++i) { kk[i] *= inv; kp[i] = k[i] * (1.0f + (a[i] - 1.0f) * c.ka[i]); b[i] = kk[i] * a[i]; wr[i] = w[i] * r[i]; br += b[i] * r[i]; kr += kp[i] * r[i]; bon += r[i] * kp[i] * c.rk[i]; }
    br = red16(br); kr = red16(kr); bon = red16(bon);
    *(LAS f32x4*)(rec + l16 * 4) = -kk; *(LAS f32x4*)(rec + 64 + l16 * 4) = wr; *(LAS f32x4*)(rec + 128 + l16 * 4) = w; *(LAS f32x4*)(rec + 192 + l16 * 4) = b; *(LAS f32x4*)(rec + 256 + l16 * 4) = kp; *(LAS f32x4*)(rec + 320 + l16 * 4) = v;
    if (l16 == 0) { rec[384] = br; rec[385] = kr; }
    return bon;
}

constexpr int CT = 32;
__device__ __forceinline__ void rwkv_prompt(const Params& P, LAS unsigned char* lds, int hd, int quarter) {
    unsigned char* ws = P.ws; const int tid = threadIdx.x, lane = tid & 63, wave = __builtin_amdgcn_readfirstlane(tid >> 6);
    const int b = hd >> 3, h = hd & 7;
    const bf16_t* F = (const bf16_t*)(ws + WS_RH + RH_F); const bf16_t* LOwa = (const bf16_t*)(ws + WS_RX); bf16_t* O = (bf16_t*)(ws + WS_RH + RH_AS5); float* BON = (float*)(ws + WS_BONUS);
    LAS float* buf = (LAS float*)lds;
    constexpr int NCH = 2048 / CT;
    if (wave >= 4) {
        const int ptid = tid - 256, l16 = ptid & 15, psub = ptid >> 4, ch = h * 64 + l16 * 4;
        PrepC pc; load_prepc(pc, P, h, l16);
        u32x2 raw[2][8];
        auto issue = [&](int c) {
#pragma unroll
            for (int j = 0; j < 2; ++j) { const int ps = psub + 16 * j; const size_t row = (size_t)b * 2048 + c * CT + ps; const bf16_t* f = F + row * RC + ch; const bf16_t* l = LOwa + row * 1024 + ch;
                raw[j][0] = *(const u32x2*)f; raw[j][1] = *(const u32x2*)(f + 512); raw[j][2] = *(const u32x2*)(f + 1024);
                if (c * CT + ps > 0) { raw[j][3] = *(const u32x2*)(f - RC); raw[j][4] = *(const u32x2*)(f - RC + 512); raw[j][5] = *(const u32x2*)(f - RC + 1024); } else { raw[j][3] = (u32x2){0u, 0u}; raw[j][4] = raw[j][3]; raw[j][5] = raw[j][3]; }
                raw[j][6] = *(const u32x2*)l; raw[j][7] = *(const u32x2*)(l + 512); } };
        auto cv = [](u32x2 w) { return (f32x4){bf_lo(w.x), bf_hi(w.x), bf_lo(w.y), bf_hi(w.y)}; };
        issue(0);
        for (int c = 0; c < NCH; ++c) {
            LAS float* cb = buf + (c & 1) * CT * REC;
#pragma unroll
            for (int j = 0; j < 2; ++j) { const int ps = psub + 16 * j; const size_t row = (size_t)b * 2048 + c * CT + ps;
                const float bon = prep_compute(pc, cv(raw[j][0]), cv(raw[j][1]), cv(raw[j][2]), cv(raw[j][3]), cv(raw[j][4]), cv(raw[j][5]), cv(raw[j][6]), cv(raw[j][7]), cb + ps * REC, l16);
                if (quarter == 0 && l16 == 0) BON[row * 8 + h] = bon; }
            if (c + 1 < NCH) issue(c + 1);
            __syncthreads();
        }
        __syncthreads();
    } else {
        const int rg = lane >> 4, kq = lane & 15, myrow = quarter * 16 + wave * 4 + rg;
        f32x4 S = {0.f, 0.f, 0.f, 0.f};
        __builtin_amdgcn_s_setprio(3);
        __syncthreads();
        for (int c = 0; c < NCH; ++c) {
            const LAS float* rec = buf + (c & 1) * CT * REC;
            f32x4 nkk = *(const LAS f32x4*)(rec + kq * 4), wr4 = *(const LAS f32x4*)(rec + 64 + kq * 4), w4 = *(const LAS f32x4*)(rec + 128 + kq * 4), b4 = *(const LAS f32x4*)(rec + 192 + kq * 4), kp4 = *(const LAS f32x4*)(rec + 256 + kq * 4);
            float vv = rec[320 + myrow]; f32x2 bk = *(const LAS f32x2*)(rec + 384);
            bf16_t* op = O + ((size_t)b * 2048 + c * CT + kq) * 512 + h * 64 + myrow;
            f32x2 S01 = {S[0], S[1]}, S23 = {S[2], S[3]};
#pragma unroll 1
            for (int s16 = 0; s16 < CT; s16 += 16) {
                float osel = 0.f;
#pragma unroll
                for (int u = 0; u < 16; ++u) {
                    const LAS float* rn = rec + (s16 + u + 1) * REC;
                    const f32x4 nkk_n = *(const LAS f32x4*)(rn + kq * 4), wr_n = *(const LAS f32x4*)(rn + 64 + kq * 4), w_n = *(const LAS f32x4*)(rn + 128 + kq * 4), b_n = *(const LAS f32x4*)(rn + 192 + kq * 4), kp_n = *(const LAS f32x4*)(rn + 256 + kq * 4);
                    const float vv_n = rn[320 + myrow]; const f32x2 bk_n = *(const LAS f32x2*)(rn + 384);
                    f32x2 tp = S01 * (f32x2){nkk[0], nkk[1]}; tp = S23 * (f32x2){nkk[2], nkk[3]} + tp;
                    f32x2 tq = S01 * (f32x2){wr4[0], wr4[1]}; tq = S23 * (f32x2){wr4[2], wr4[3]} + tq;
                    float p = tp.x + tp.y, q = tq.x + tq.y;
                    p = dpp_allreduce16(p); q = dpp_allreduce16(q);
                    const f32x2 pp = {p, p}, v2 = {vv, vv};
                    S01 = S01 * (f32x2){w4[0], w4[1]} + ((f32x2){b4[0], b4[1]} * pp + (f32x2){kp4[0], kp4[1]} * v2);
                    S23 = S23 * (f32x2){w4[2], w4[3]} + ((f32x2){b4[2], b4[3]} * pp + (f32x2){kp4[2], kp4[3]} * v2);
                    const float o = q + p * bk.x + vv * bk.y;
                    osel = (kq == u) ? o : osel;
                    nkk = nkk_n; wr4 = wr_n; w4 = w_n; b4 = b_n; kp4 = kp_n; vv = vv_n; bk = bk_n;
                }
                op[(size_t)s16 * 512] = (bf16_t)(cvt_pk_bf16(osel, 0.f) & 0xffffu);
            }
            S = (f32x4){S01.x, S01.y, S23.x, S23.y};
            __syncthreads();
        }
        *(f32x4*)(P.out + O_WKVP + ((size_t)(hd * 64 + myrow)) * 64 + kq * 4) = S;
        __builtin_amdgcn_s_setprio(0);
    }
}

__device__ __forceinline__ void rwkv_sample(const Params& P, LAS unsigned char* lds, int i, int h) {
    unsigned char* ws = P.ws; const int tid = threadIdx.x;
    const bf16_t* F = (const bf16_t*)(ws + WS_RH + RH_F); const bf16_t* LOwa = (const bf16_t*)(ws + WS_RX); bf16_t* O = (bf16_t*)(ws + WS_RH + RH_AS5); float* BON = (float*)(ws + WS_BONUS);
    LAS float* rec = (LAS float*)lds; const size_t row = (size_t)MPROMPT + i;
    if (tid < 16) { const int l16 = tid, ch = h * 64 + l16 * 4; PrepC pc; load_prepc(pc, P, h, l16);
        const bf16_t* f = F + row * RC + ch; const float* sp = P.in[2] + (size_t)i * RC + ch; const bf16_t* l = LOwa + row * 1024 + ch;
        const float bon = prep_compute(pc, load4bf(f), load4bf(f + 512), load4bf(f + 1024), *(const f32x4*)sp, *(const f32x4*)(sp + 512), *(const f32x4*)(sp + 1024), load4bf(l), load4bf(l + 512), rec, l16);
        if (l16 == 0) BON[row * 8 + h] = bon; }
    __syncthreads();
    { const int v = tid >> 3, k0 = (tid & 7) * 8; const size_t so = ((size_t)((i * 8 + h) * 64 + v)) * 64 + k0;
      f32x4 S0 = *(const f32x4*)(P.in[3] + so), S1 = *(const f32x4*)(P.in[3] + so + 4);
      const f32x4 n0 = *(const LAS f32x4*)(rec + k0), n1 = *(const LAS f32x4*)(rec + k0 + 4), r0 = *(const LAS f32x4*)(rec + 64 + k0), r1 = *(const LAS f32x4*)(rec + 68 + k0);
      const f32x4 w0 = *(const LAS f32x4*)(rec + 128 + k0), w1 = *(const LAS f32x4*)(rec + 132 + k0), b0 = *(const LAS f32x4*)(rec + 192 + k0), b1 = *(const LAS f32x4*)(rec + 196 + k0), k0v = *(const LAS f32x4*)(rec + 256 + k0), k1v = *(const LAS f32x4*)(rec + 260 + k0);
      const float vv = rec[320 + v], br = rec[384], kr = rec[385];
      float p = 0.f, q = 0.f;
#pragma unroll
      for (int j = 0; j < 4; ++j) { p += S0[j] * n0[j] + S1[j] * n1[j]; q += S0[j] * r0[j] + S1[j] * r1[j]; }
      p += __shfl_xor(p, 1); p += __shfl_xor(p, 2); p += __shfl_xor(p, 4); q += __shfl_xor(q, 1); q += __shfl_xor(q, 2); q += __shfl_xor(q, 4);
      S0 = S0 * w0 + (b0 * p + k0v * vv); S1 = S1 * w1 + (b1 * p + k1v * vv);
      *(f32x4*)(P.out + O_WKVS + so) = S0; *(f32x4*)(P.out + O_WKVS + so + 4) = S1;
      if ((tid & 7) == 0) O[row * 512 + h * 64 + v] = (bf16_t)(cvt_pk_bf16(q + p * br + vv * kr, 0.f) & 0xffffu); }
    __syncthreads();
}

__device__ __forceinline__ void rwkv_sample4(const Params& P, LAS unsigned char* lds, int t0) {
    unsigned char* ws = P.ws; const int tid = threadIdx.x;
    const bf16_t* F = (const bf16_t*)(ws + WS_RH + RH_F); const bf16_t* LOwa = (const bf16_t*)(ws + WS_RX); bf16_t* O = (bf16_t*)(ws + WS_RH + RH_AS5); float* BON = (float*)(ws + WS_BONUS);
    const int v = tid >> 3, k0 = (tid & 7) * 8;
    f32x4 S0[4], S1[4];
#pragma unroll
    for (int j = 0; j < 4; ++j) { const int t = t0 + 256 * j; const size_t so = ((size_t)(t * 64 + v)) * 64 + k0; S0[j] = *(const f32x4*)(P.in[3] + so); S1[j] = *(const f32x4*)(P.in[3] + so + 4); }
    if (tid < 64) { const int j = tid >> 4, l16 = tid & 15, t = t0 + 256 * j, i = t >> 3, h = t & 7, ch = h * 64 + l16 * 4; const size_t row = (size_t)MPROMPT + i;
        PrepC pc; load_prepc(pc, P, h, l16);
        const bf16_t* f = F + row * RC + ch; const float* sp = P.in[2] + (size_t)i * RC + ch; const bf16_t* l = LOwa + row * 1024 + ch;
        const float bon = prep_compute(pc, load4bf(f), load4bf(f + 512), load4bf(f + 1024), *(const f32x4*)sp, *(const f32x4*)(sp + 512), *(const f32x4*)(sp + 1024), load4bf(l), load4bf(l + 512), (LAS float*)lds + j * 392, l16);
        if (l16 == 0) BON[row * 8 + h] = bon; }
    __syncthreads();
#pragma unroll
    for (int j = 0; j < 4; ++j) { const int t = t0 + 256 * j, i = t >> 3, h = t & 7; const size_t row = (size_t)MPROMPT + i; const size_t so = ((size_t)(t * 64 + v)) * 64 + k0; const LAS float* rec = (const LAS float*)lds + j * 392;
        const f32x4 n0 = *(const LAS f32x4*)(rec + k0), n1 = *(const LAS f32x4*)(rec + k0 + 4), r0 = *(const LAS f32x4*)(rec + 64 + k0), r1 = *(const LAS f32x4*)(rec + 68 + k0);
        const f32x4 w0 = *(const LAS f32x4*)(rec + 128 + k0), w1 = *(const LAS f32x4*)(rec + 132 + k0), b0 = *(const LAS f32x4*)(rec + 192 + k0), b1 = *(const LAS f32x4*)(rec + 196 + k0), k0v = *(const LAS f32x4*)(rec + 256 + k0), k1v = *(const LAS f32x4*)(rec + 260 + k0);
        const float vv = rec[320 + v], br = rec[384], kr = rec[385];
        float p = 0.f, q = 0.f;
#pragma unroll
        for (int e = 0; e < 4; ++e) { p += S0[j][e] * n0[e] + S1[j][e] * n1[e]; q += S0[j][e] * r0[e] + S1[j][e] * r1[e]; }
        p += __shfl_xor(p, 1); p += __shfl_xor(p, 2); p += __shfl_xor(p, 4); q += __shfl_xor(q, 1); q += __shfl_xor(q, 2); q += __shfl_xor(q, 4);
        *(f32x4*)(P.out + O_WKVS + so) = S0[j] * w0 + (b0 * p + k0v * vv); *(f32x4*)(P.out + O_WKVS + so + 4) = S1[j] * w1 + (b1 * p + k1v * vv);
        if ((tid & 7) == 0) O[row * 512 + h * 64 + v] = (bf16_t)(cvt_pk_bf16(q + p * br + vv * kr, 0.f) & 0xffffu); }
    __syncthreads();
}

__device__ __forceinline__ void s5_sample(const Params& P, int i, int g, int lane) {
    unsigned char* ws = P.ws; const float* Us = (const float*)(ws + WS_US); const float* abar = (const float*)(ws + WS_ABAR); const float* bbt = (const float*)(ws + WS_BBT); bf16_t* Z = (bf16_t*)(ws + WS_Z);
    const int gp = g * 64 + lane; const size_t so = (size_t)(i * 32 + g) * 64 + lane;
    const float x0r = P.in[4][so], x0i = P.in[5][so], ar = abar[gp * 2], ai = abar[gp * 2 + 1];
    float bur = 0.f, bui = 0.f; float uu[16];
#pragma unroll
    for (int h = 0; h < 16; ++h) { uu[h] = Us[(size_t)i * 512 + g * 16 + h]; bur += bbt[(gp * 16 + h) * 2] * uu[h]; bui += bbt[(gp * 16 + h) * 2 + 1] * uu[h]; }
    const float xr = ar * x0r - ai * x0i + bur, xi = ar * x0i + ai * x0r + bui;
    P.out[O_S5RS + so] = xr; P.out[O_S5IS + so] = xi;
    float mine = 0.f, myu = 0.f;
#pragma unroll
    for (int h = 0; h < 16; ++h) { float v = xr * P.in[28][(g * 16 + h) * 64 + lane] - xi * P.in[29][(g * 16 + h) * 64 + lane]; v = red64(v); if (lane == h) { mine = v; myu = uu[h]; } }
    if (lane < 16) { const float y = mine + P.in[30][g * 16 + lane] * myu; Z[((size_t)MPROMPT + i) * 512 + g * 16 + lane] = (bf16_t)(cvt_pk_bf16(geluf_(y), 0.f) & 0xffffu); }
}

__device__ __forceinline__ void phase_post(const Params& P) {
    unsigned char* ws = P.ws; const size_t gtid = (size_t)blockIdx.x * NTHR + threadIdx.x, gthreads = (size_t)gridDim.x * NTHR; const int l16 = threadIdx.x & 15;
    const bf16_t* F = (const bf16_t*)(ws + WS_RH + RH_F); const bf16_t* O = (const bf16_t*)(ws + WS_RH + RH_AS5); const bf16_t* LOg = (const bf16_t*)(ws + WS_WFFN); const float* BON = (const float*)(ws + WS_BONUS); bf16_t* YAB = (bf16_t*)(ws + WS_RX);
    const size_t ngrp = (size_t)MV * 8, gstride = gthreads >> 4;
    for (size_t grp0 = gtid >> 4; grp0 < ngrp; grp0 += 2 * gstride) {
        f32x4 o[2], fv[2], pv[2], g[2]; float bon[2]; int rowv[2], chv[2]; bool ok[2];
#pragma unroll
        for (int q = 0; q < 2; ++q) { const size_t grp = grp0 + q * gstride; ok[q] = grp < ngrp; const size_t gg = ok[q] ? grp : grp0; const int row = (int)(gg >> 3), h = (int)(gg & 7), ch = h * 64 + l16 * 4; rowv[q] = row; chv[q] = ch;
            o[q] = load4bf(O + (size_t)row * 512 + ch); fv[q] = load4bf(F + (size_t)row * RC + 1024 + ch);
            if (row < MPROMPT) { if ((row & 2047) > 0) pv[q] = load4bf(F + (size_t)(row - 1) * RC + 1024 + ch); else pv[q] = (f32x4){0.f, 0.f, 0.f, 0.f}; } else pv[q] = *(const f32x4*)(P.in[2] + (size_t)(row - MPROMPT) * RC + 1024 + ch);
            g[q] = load4bf(LOg + (size_t)row * 512 + ch); bon[q] = BON[(size_t)row * 8 + h]; }
#pragma unroll
        for (int q = 0; q < 2; ++q) { const int row = rowv[q], ch = chv[q];
            const float mean = red16((o[q][0] + o[q][1]) + (o[q][2] + o[q][3])) * (1.0f / 64.0f); const f32x4 d = o[q] - mean;
            const float var = red16((d[0] * d[0] + d[1] * d[1]) + (d[2] * d[2] + d[3] * d[3])) * (1.0f / 64.0f); const float rstd = rsqrtf(var + 64e-5f);
            const f32x4 muv = *(const f32x4*)(P.in[12] + 1024 + ch); const f32x4 v = fv[q] + muv * (pv[q] - fv[q]);
            const f32x4 lw = *(const f32x4*)(P.in[21] + ch), lb = *(const f32x4*)(P.in[22] + ch);
            const f32x4 ya = (d * rstd * lw + lb + v * bon[q]) * g[q];
            if (ok[q]) store4bf(YAB + (size_t)row * 1024 + ch, ya); }
    }
}


__device__ __forceinline__ void comb_resid(const float* slab, int S, const float* base_f32, float alpha, bf16_t* XHs, float* SSPs) {
    const int lane = threadIdx.x & 63, wave = threadIdx.x >> 6;
    for (int r = blockIdx.x * 8 + wave; r < NSAMP; r += gridDim.x * 8) { float ssq = 0.f;
#pragma unroll
        for (int i = 0; i < 4; ++i) { const int c = i * 256 + lane * 4; f32x4 a = {0.f, 0.f, 0.f, 0.f};
            for (int sl = 0; sl < S; ++sl) a += *(const f32x4*)(slab + ((size_t)(sl * 128 + r)) * 1024 + c);
            const f32x4 b = base_f32 ? *(const f32x4*)(base_f32 + (size_t)r * 1024 + c) : load4bf(XHs + (size_t)r * 2048 + c);
            const f32x4 o = b + a * alpha; store4bf(XHs + (size_t)r * 2048 + c, o);
            ssq += (o[0] * o[0] + o[1] * o[1]) + (o[2] * o[2] + o[3] * o[3]); }
        ssq = red64(ssq); if (lane < 16) SSPs[(size_t)r * 16 + lane] = lane == 0 ? ssq : 0.f; }
}
__device__ __forceinline__ void comb_gate(const float* slab, const bf16_t* Gt, bf16_t* Mg) {
    for (int i = blockIdx.x * NTHR + threadIdx.x; i < NSAMP * 256; i += gridDim.x * NTHR) { const int r = i >> 8, c = (i & 255) * 4; const size_t row = (size_t)MPROMPT + r;
        const f32x4 pa = *(const f32x4*)(slab + (size_t)r * 1024 + c) + *(const f32x4*)(slab + (size_t)(128 + r) * 1024 + c);
        const f32x4 pb = *(const f32x4*)(slab + (size_t)(256 + r) * 1024 + c) + *(const f32x4*)(slab + (size_t)(384 + r) * 1024 + c);
        const f32x4 ga = load4bf(Gt + row * 2048 + c), gb = load4bf(Gt + row * 2048 + 1024 + c);
        store4bf(Mg + row * 1024 + c, ga * pa + gb * pb); }
}

__device__ __forceinline__ void phase_final(const Params& P) {
    const float* ss = (const float*)(P.ws + WS_SS4); const float* slab = (const float*)(P.ws + WS_SLAB); const int lane = threadIdx.x & 63, wave = threadIdx.x >> 6;
    for (int row = MPROMPT + blockIdx.x * 8 + wave; row < MV; row += gridDim.x * 8) { float* x = P.out + (size_t)row * DM;
        if (row < MPROMPT) { const float s = row_rs(ss, row);
#pragma unroll
            for (int i = 0; i < 4; ++i) { const int c = i * 256 + lane * 4; const f32x4 v = *(const f32x4*)(x + c), gf = *(const f32x4*)(P.in[39] + c); *(f32x4*)(x + c) = v * s * gf; } }
        else { const int r = row - MPROMPT; f32x4 o[4]; float ssq = 0.f;
#pragma unroll
            for (int i = 0; i < 4; ++i) { const int c = i * 256 + lane * 4; f32x4 a = {0.f, 0.f, 0.f, 0.f};
                for (int sl = 0; sl < 11; ++sl) a += *(const f32x4*)(slab + ((size_t)(sl * 128 + r)) * 1024 + c);
                o[i] = load4bf((const bf16_t*)x + 1024 + c) + a * 0.5f; ssq += (o[i][0] * o[i][0] + o[i][1] * o[i][1]) + (o[i][2] * o[i][2] + o[i][3] * o[i][3]); }
            ssq = red64(ssq); const float s = rsqrtf(ssq * (1.0f / 1024.0f) + 1e-6f);
#pragma unroll
            for (int i = 0; i < 4; ++i) { const int c = i * 256 + lane * 4; const f32x4 gf = *(const f32x4*)(P.in[39] + c); *(f32x4*)(x + c) = o[i] * s * gf; } } }
}


#define XB_TMO      128
#define XB_XCNT(j)  (256  + 64 * (j))
#define XB_XSUB(j)  (1280 + 64 * (j))
#define XB_XGEN(j)  (2304 + 64 * (j))
#define XB_TOP      3328
#define XB_TOPGEN   3392
#define XCD_BAR_WORDS 3456
#define XB_SPIN_CAP (1u << 18)

__device__ __forceinline__ unsigned xb_ld(unsigned* p)              { return __hip_atomic_load(p, __ATOMIC_RELAXED, __HIP_MEMORY_SCOPE_AGENT); }
__device__ __forceinline__ unsigned xb_add(unsigned* p, unsigned v) { return __hip_atomic_fetch_add(p, v, __ATOMIC_RELAXED, __HIP_MEMORY_SCOPE_AGENT); }
__device__ __forceinline__ unsigned xb_xcc_id() { return (unsigned)__builtin_amdgcn_s_getreg((3 << 11) | 20) & 0xFu; }
#define XB_SPIN(cond, bar) do { unsigned _sp = 0; while (cond) { __builtin_amdgcn_s_sleep(1); \
    if ((++_sp & 255u) == 0u) { if (xb_ld(&(bar)[XB_TMO])) break; if (_sp > XB_SPIN_CAP) { atomicAdd(&(bar)[XB_TMO], 1u); break; } } } } while (0)

struct XcdBarrier {
    unsigned* bar; unsigned x;
    volatile LAS unsigned* st;
};

__device__ __forceinline__ XcdBarrier xcd_barrier_post(unsigned* bar, volatile LAS unsigned* st) {
    XcdBarrier b; b.bar = bar; b.x = xb_xcc_id(); b.st = st;
    if (threadIdx.x == 0) (void)xb_add(&bar[XB_XCNT(b.x)], 1u);
    return b;
}
__device__ __forceinline__ void xcd_barrier_complete(unsigned* bar, unsigned x, unsigned& nloc, unsigned& nx) {
    const unsigned G = gridDim.x * gridDim.y * gridDim.z;
    unsigned sum, cnt, mine, sp = 0u;
    for (;;) {
        sum = 0u; cnt = 0u; mine = 0u;
#pragma unroll
        for (unsigned j = 0; j < 16; ++j) { const unsigned c = xb_ld(&bar[XB_XCNT(j)]); sum += c; cnt += (c > 0u) ? 1u : 0u; mine = (j == x) ? c : mine; }
        if (sum == G) break;
        __builtin_amdgcn_s_sleep(1);
        if ((++sp & 255u) == 0u) { if (xb_ld(&bar[XB_TMO])) break; if (sp > XB_SPIN_CAP) { atomicAdd(&bar[XB_TMO], 1u); break; } }
    }
    nloc = mine > 0u ? mine : 1u; nx = cnt > 0u ? cnt : 1u;
}

__device__ __forceinline__ void xcd_barrier(const XcdBarrier& b) {
    asm volatile("s_waitcnt vmcnt(0)" ::: "memory");
    __syncthreads();
    if (threadIdx.x == 0) {
        unsigned* bar = b.bar;
        __builtin_amdgcn_s_waitcnt(0);
        unsigned nloc = b.st[0], nx = b.st[1];
        if (nloc == 0u) { xcd_barrier_complete(bar, b.x, nloc, nx); b.st[0] = nloc; b.st[1] = nx; }
        const unsigned old = xb_add(&bar[XB_XSUB(b.x)], 1u);
        const unsigned gen = old / nloc;
        if (old + 1u == (gen + 1u) * nloc) {
            __builtin_amdgcn_fence(__ATOMIC_RELEASE, "agent");
            asm volatile("s_waitcnt vmcnt(0)" ::: "memory");
            const unsigned og = xb_add(&bar[XB_TOP], 1u);
            const unsigned tg = og / nx;
            if (og + 1u == (tg + 1u) * nx) xb_add(&bar[XB_TOPGEN], 1u);
            else XB_SPIN(xb_ld(&bar[XB_TOPGEN]) == tg, bar);
            __builtin_amdgcn_fence(__ATOMIC_ACQUIRE, "agent");
            xb_add(&bar[XB_XGEN(b.x)], 1u);
            asm volatile("s_waitcnt vmcnt(0)" ::: "memory");
        } else {
            XB_SPIN(xb_ld(&bar[XB_XGEN(b.x)]) == gen, bar);
            __builtin_amdgcn_fence(__ATOMIC_ACQUIRE, "agent");
            asm volatile("s_waitcnt vmcnt(0)" ::: "memory");
        }
    }
    __syncthreads();
}


template <int ONE_LAUNCH> __global__ void __launch_bounds__(NTHR, 2) fwd_megakernel(Params P, int seg) {
    extern __shared__ __attribute__((aligned(16))) unsigned char lds_raw[];
    LAS unsigned char* lds = (LAS unsigned char*)lds_raw;
    volatile LAS unsigned* bst = (volatile LAS unsigned*)(lds + 131072);
    if (threadIdx.x < 2) bst[threadIdx.x] = 0u;
    __syncthreads();
    XcdBarrier xbar; xbar.bar = (unsigned*)(P.ws + WS_CTL); xbar.x = 0; xbar.st = bst;
    if (ONE_LAUNCH) xbar = xcd_barrier_post((unsigned*)(P.ws + WS_CTL), bst);
    unsigned char* ws = P.ws; const int G = gridDim.x, bid = blockIdx.x;
    bf16_t* RX = (bf16_t*)(ws + WS_RX); bf16_t* RH = (bf16_t*)(ws + WS_RH);
    bf16_t* Fb = (bf16_t*)(ws + WS_RH + RH_F); bf16_t* As5 = (bf16_t*)(ws + WS_RH + RH_AS5); bf16_t* Lin = (bf16_t*)(ws + WS_RH + RH_LIN);
    bf16_t* Tb = RH; bf16_t* Mg = (bf16_t*)(ws + WS_RH + RH_MG); bf16_t* Gt = (bf16_t*)(ws + WS_RG); bf16_t* Zb = (bf16_t*)(ws + WS_Z);
    float* SS2 = (float*)(ws + WS_SS2); float* SS3 = (float*)(ws + WS_SS3); float* SS4 = (float*)(ws + WS_SS4);
    StaticOrder so; float* SLAB = (float*)(ws + WS_SLAB); bf16_t* XH = (bf16_t*)P.out;
    int cur_seg = 0;
#define GSYNC() do { if (ONE_LAUNCH) xcd_barrier(xbar); else ++cur_seg; } while (0)
#define RUN (ONE_LAUNCH || cur_seg == seg)
#undef PH
#define PH(n) if (RUN)

    PH(0) phase_prep(P, lds);
    GSYNC();
    PH(1) { Gemm g{RX, (const bf16_t*)(ws + WS_WFFN), 1024, 1024, 1024}; so.init(65, 22, G, bid); EpiFfnUp e{RH, (const float*)(ws + WS_RS1), 0}; gemm_phase(lds, g, so, e);
            if (bid >= 150) conv_job(P, (LAS float*)lds, 3, bid - 150, G - 150); }
    GSYNC();
    PH(2) { Gemm g{RH, (const bf16_t*)(ws + WS_WDT), FF, FF, FF}; so.init(64, 4, G, bid); EpiResid e{RX, XH, SS2, 0.5f, 1}; gemm_phase(lds, g, so, e);
            Gemm gs{RH, (const bf16_t*)(ws + WS_WDT), FF, FF, 256}; SplitOrder sp{4, 11, 256, G, bid}; EpiSlab es{SLAB, 256}; gemm_phase(lds, gs, sp, es);
            if (bid >= 44) for (int j = 4; j < 8; ++j) conv_job(P, (LAS float*)lds, j, bid - 44, G - 44); }
    GSYNC();
    PH(2) comb_resid(SLAB, 11, P.in[1], 0.5f, XH + (size_t)MPROMPT * 2048 + 1024, SS2 + (size_t)MPROMPT * 16);
    GSYNC();
    PH(3) { Gemm g{XH + 1024, (const bf16_t*)(ws + WS_WIN), 2048, 1024, 1024}; so.init(65, 17, G, bid); EpiWin e{SS2, Fb, As5, (float*)(ws + WS_US), Gt}; gemm_phase(lds, g, so, e);
            if (bid >= 81) phase_prep2(P, lds, bid - 81, G - 81); }
    GSYNC();
    PH(4) { Gemm g{As5 + 128, (const bf16_t*)(ws + WS_S5W1), 384, 256, 256}; DiagOrder d{128, G, bid}; EpiS5a e{P.out + O_WKVS}; gemm_phase(lds, g, d, e);
            if (bid < 128) {
                asm volatile("s_waitcnt vmcnt(0)" ::: "memory"); __syncthreads();
                if (threadIdx.x < 128) phase_carry(P, 2 * (bid & 3) + (threadIdx.x >> 6), bid >> 2, threadIdx.x & 63); } }
    PH(5) { phase_mix(P);
            if (bid >= 128) for (int t = (bid - 128) * 8 + (threadIdx.x >> 6); t < NSAMP * 32; t += (G - 128) * 8) s5_sample(P, t >> 5, t & 31, threadIdx.x & 63); }
    GSYNC();
    PH(7) { Gemm g{As5, (const bf16_t*)(ws + WS_S5W2), 384, 384, 384}; DiagOrder d{128, G, bid}; EpiS5b e{As5, P.in[30], Zb}; gemm_phase(lds, g, d, e); }
    PH(8) { Gemm g{Lin, (const bf16_t*)(ws + WS_WL), 256, 256, 256}; so.init(65, 6, G, (bid + 128) % G); EpiLora e{RX, (bf16_t*)(ws + WS_WFFN)}; gemm_phase(lds, g, so, e); }
    GSYNC();
    PH(9) { rwkv_prompt(P, lds, bid >> 2, bid & 3);
        rwkv_sample4(P, lds, bid); }
    GSYNC();
    PH(11) { Gemm g{Zb, (const bf16_t*)(ws + WS_WGLU), 512, 512, 512}; so.init(65, 2, G, bid); EpiGlu e{Zb, RX}; gemm_phase(lds, g, so, e); }
    PH(12) phase_post(P);
    GSYNC();
    PH(13) { LAS float* tile = (LAS float*)lds;
      for (int j = 8; j < 11; ++j) conv_job(P, tile, j, bid, G); }
    PH(14) { Gemm g{RX, (const bf16_t*)(ws + WS_WA), 1024, 512, 512}; so.init(64, 4, G, bid); AccT gacc; EpiGateRatio e{Gt}; gemm_phase_acc(lds, g, so, e, gacc, true);
             Gemm g2{RX + 512, (const bf16_t*)(ws + WS_WB), 1024, 512, 512}; EpiGateOut e2{Gt, Mg}; gemm_phase_acc(lds, g2, so, e2, gacc, false);
             Gemm ga{RX, (const bf16_t*)(ws + WS_WA), 1024, 512, 256}; SplitOrder spa{4, 2, 256, G, bid}; EpiSlabGate ea{ws, 0}; gemm_phase(lds, ga, spa, ea);
             Gemm gb{RX + 512, (const bf16_t*)(ws + WS_WB), 1024, 512, 256}; SplitOrder spb{4, 2, 256, G, (bid + G - 8) % G}; EpiSlabGate eb{ws, 8}; gemm_phase(lds, gb, spb, eb); }
    GSYNC();
    PH(16) { Gemm g{Mg, (const bf16_t*)(ws + WS_WOUT), 1024, 1024, 1024}; so.init(64, 4, G, bid); EpiResid e{RX, XH, SS3, 1.0f, 0}; gemm_phase(lds, g, so, e);
             Gemm gs{Mg, (const bf16_t*)(ws + WS_WOUT), 1024, 1024, 256}; SplitOrder sp{4, 4, 256, G, bid}; EpiSlab es{SLAB, 256}; gemm_phase(lds, gs, sp, es); }
    GSYNC();
    PH(16) comb_resid(SLAB, 4, nullptr, 1.0f, XH + (size_t)MPROMPT * 2048 + 1024, SS3 + (size_t)MPROMPT * 16);
    GSYNC();
    PH(17) { Gemm g{XH + 1024, (const bf16_t*)(ws + WS_WFFN), 2048, 1024, 1024}; so.init(65, 22, G, bid); EpiFfnUp e{RH, SS3, 1}; gemm_phase(lds, g, so, e); }
    GSYNC();
    PH(18) { Gemm g{RH, (const bf16_t*)(ws + WS_WDT), FF, FF, FF}; so.init(64, 4, G, bid); EpiFinal e{P.out, P.in[39], (float*)(ws + WS_XSLOT), (unsigned*)(ws + WS_PCNT)}; gemm_phase(lds, g, so, e);
             Gemm gs{RH, (const bf16_t*)(ws + WS_WDT), FF, FF, 256}; SplitOrder sp{4, 11, 256, G, bid}; EpiSlab es{SLAB, 256}; gemm_phase(lds, gs, sp, es); }
    GSYNC();
    PH(19) phase_final(P);
}

extern "C" void kernel_launch(void* const* d_in, const int* in_sizes, int n_in, void* d_out, int out_size, void* d_ws, size_t ws_size, hipStream_t stream) {
    static int grid_blocks = 0;
    if (grid_blocks == 0) {
        if (n_in != 40 || ws_size < WS_END) { fprintf(stderr, "kernel_launch: unexpected n_in %d / ws_size %zu (need %zu)\n", n_in, ws_size, (size_t)WS_END); grid_blocks = -1; return; }
        int dev = 0, cus = 0;
        (void)hipGetDevice(&dev); (void)hipDeviceGetAttribute(&cus, hipDeviceAttributeMultiprocessorCount, dev);
        if (hipFuncSetAttribute((const void*)fwd_megakernel<1>, hipFuncAttributeMaxDynamicSharedMemorySize, LDS_BYTES) != hipSuccess) { fprintf(stderr, "hipFuncSetAttribute failed\n"); grid_blocks = -1; return; }
        (void)hipGetLastError();
        grid_blocks = cus > 256 ? 256 : cus;
    }
    if (grid_blocks < 0) return;
    Params p{};
    for (int i = 0; i < 40; ++i) p.in[i] = (const float*)d_in[i];
    p.out = (float*)d_out; p.ws = (unsigned char*)d_ws;
    if (hipMemsetAsync((char*)d_ws + WS_CTL, 0, 32768, stream) != hipSuccess) { fprintf(stderr, "memset failed\n"); return; }
    int seg = 0; void* args[] = {&p, &seg};
    hipError_t e = hipLaunchCooperativeKernel((const void*)fwd_megakernel<1>, dim3(grid_blocks), dim3(NTHR), args, LDS_BYTES, stream);
    if (e != hipSuccess) fprintf(stderr, "cooperative launch failed: %s (grid %d)\n", hipGetErrorString(e), grid_blocks);
}
```

```cpp
#include <hip/hip_runtime.h>
#include <hip/hip_cooperative_groups.h>
#include <cstdio>
namespace cg = cooperative_groups;

#define LAS __attribute__((address_space(3)))
typedef unsigned short bf16_t;
typedef short bf16x8 __attribute__((ext_vector_type(8)));
typedef float f32x4 __attribute__((ext_vector_type(4)));
typedef float f32x2 __attribute__((ext_vector_type(2)));
typedef unsigned u32x4 __attribute__((ext_vector_type(4)));
typedef unsigned u32x2 __attribute__((ext_vector_type(2)));

constexpr int DM = 1024, MPROMPT = 16384, NSAMP = 128, MV = 16512, MP = 16640;
constexpr int FF = 2816, RC = 1792;
constexpr int NTHR = 512;
constexpr int LDS_BYTES = 131072 + 16;
#ifndef PHMASK
#define PHMASK 0xffffffffu
#endif
#define PH(n) if (PHMASK & (1u << (n)))

constexpr size_t WS_WFFN = 0;
constexpr size_t WS_WDT = WS_WFFN + (size_t)5632 * 1024 * 2;
constexpr size_t WS_WIN = WS_WFFN + (size_t)17301504;
constexpr size_t WS_WL = WS_WIN + (size_t)4352 * 1024 * 2;
constexpr size_t WS_WGLU = WS_WL + (size_t)1536 * 256 * 2;
constexpr size_t WS_WA = WS_WGLU + (size_t)512 * 512 * 2;
constexpr size_t WS_WB = WS_WA + (size_t)1024 * 512 * 2;
constexpr size_t WS_WOUT = WS_WB + (size_t)1024 * 512 * 2;
constexpr size_t WS_S5W1 = WS_WOUT + (size_t)1024 * 1024 * 2;
constexpr size_t WS_S5W2 = WS_S5W1 + (size_t)8192 * 256 * 2;
constexpr size_t WS_KT = WS_S5W2 + (size_t)8192 * 384 * 2;
constexpr size_t WS_BBT = WS_KT + (size_t)131072 * 4;
constexpr size_t WS_ABAR = WS_BBT + (size_t)65536 * 4;
constexpr size_t WS_ABAR16 = WS_ABAR + (size_t)4096 * 4;
constexpr size_t WS_RS1 = WS_ABAR16 + (size_t)4096 * 4;
constexpr size_t WS_SS2 = WS_RS1 + (size_t)MP * 4;
constexpr size_t WS_SS3 = WS_SS2 + (size_t)MP * 64;
constexpr size_t WS_SS4 = WS_SS3 + (size_t)MP * 64;
constexpr size_t WS_BONUS = WS_SS4 + (size_t)MP * 64;
constexpr size_t WS_US = WS_BONUS + (size_t)MP * 8 * 4;
constexpr size_t WS_RX = WS_US + (size_t)128 * 512 * 4;
constexpr size_t WS_RH = WS_RX + (size_t)MP * 1024 * 2;
constexpr size_t RH_F = 0, RH_AS5 = (size_t)MP * RC * 2, RH_LIN = RH_AS5 + (size_t)32768 * 384 * 2, RH_MG = (size_t)MP * 1024 * 2;
constexpr size_t WS_RG = WS_RH + (size_t)MP * FF * 2;
constexpr size_t WS_Z = WS_RG + (size_t)MP * 2048 * 2;
constexpr size_t WS_CTL = WS_Z + (size_t)MP * 512 * 2;
constexpr size_t WS_PCNT = WS_CTL + 16384;
constexpr size_t WS_XSLOT = WS_CTL + 32768;
constexpr size_t WS_SLAB = WS_XSLOT + (size_t)16384 * 4 * 4;
constexpr size_t WS_END = WS_SLAB + (size_t)11 * 128 * 1024 * 4;
static_assert(RH_LIN + (size_t)MP * 256 * 2 <= (size_t)MP * FF * 2, "R_H overflow");
static_assert(WS_END <= (size_t)268435456, "workspace plan exceeds 256 MiB");

constexpr size_t O_Y = 0, O_SHP = 16908288, O_WKVP = 16922624, O_S5RP = 17184768, O_S5IP = 17201152, O_SHS = 17217536, O_WKVS = 17446912, O_S5RS = 21641216, O_S5IS = 21903360;

struct Params {
    const float* in[40];
    float* out;
    unsigned char* ws;
};

typedef __bf16 bf16x2_t __attribute__((ext_vector_type(2)));
__device__ __forceinline__ unsigned cvt_pk_bf16(float lo, float hi) { const f32x2 v = {lo, hi}; const bf16x2_t b = __builtin_convertvector(v, bf16x2_t); return __builtin_bit_cast(unsigned, b); }
__device__ __forceinline__ float bf_lo(unsigned w) { return __uint_as_float(w << 16); }
__device__ __forceinline__ float bf_hi(unsigned w) { return __uint_as_float(w & 0xffff0000u); }
__device__ __forceinline__ float sigmoidf_(float x) { return __builtin_amdgcn_rcpf(1.0f + __expf(-x)); }
__device__ __forceinline__ float siluf_(float x) { return x * sigmoidf_(x); }
__device__ __forceinline__ float tanhf_(float x) { return 1.0f - 2.0f * __builtin_amdgcn_rcpf(1.0f + __expf(2.0f * x)); }
__device__ __forceinline__ float geluf_(float y) { return y * sigmoidf_(1.5957691216f * (y + 0.044715f * y * y * y)); }
__device__ __forceinline__ void store8(bf16_t* p, f32x4 a, f32x4 b) { u32x4 w; w.x = cvt_pk_bf16(a[0], a[1]); w.y = cvt_pk_bf16(a[2], a[3]); w.z = cvt_pk_bf16(b[0], b[1]); w.w = cvt_pk_bf16(b[2], b[3]); *(u32x4*)p = w; }
__device__ __forceinline__ void load8(const bf16_t* p, f32x4& a, f32x4& b) { const u32x4 w = *(const u32x4*)p; a = (f32x4){bf_lo(w.x), bf_hi(w.x), bf_lo(w.y), bf_hi(w.y)}; b = (f32x4){bf_lo(w.z), bf_hi(w.z), bf_lo(w.w), bf_hi(w.w)}; }
__device__ __forceinline__ f32x4 load4bf(const bf16_t* p) { const u32x2 w = *(const u32x2*)p; return (f32x4){bf_lo(w.x), bf_hi(w.x), bf_lo(w.y), bf_hi(w.y)}; }
__device__ __forceinline__ void store4bf(bf16_t* p, f32x4 a) { u32x2 w; w.x = cvt_pk_bf16(a[0], a[1]); w.y = cvt_pk_bf16(a[2], a[3]); *(u32x2*)p = w; }
__device__ __forceinline__ float red16(float x) { x += __shfl_xor(x, 1); x += __shfl_xor(x, 2); x += __shfl_xor(x, 4); x += __shfl_xor(x, 8); return x; }
__device__ __forceinline__ float red64(float x) { x = red16(x); x += __shfl_xor(x, 16); x += __shfl_xor(x, 32); return x; }
__device__ __forceinline__ float row_rs(const float* ssp, int row) { const f32x4 a = *(const f32x4*)(ssp + (size_t)row * 16), b = *(const f32x4*)(ssp + (size_t)row * 16 + 4), c = *(const f32x4*)(ssp + (size_t)row * 16 + 8), d = *(const f32x4*)(ssp + (size_t)row * 16 + 12);
    const f32x4 t = (a + b) + (c + d); return rsqrtf(((t[0] + t[1]) + (t[2] + t[3])) * (1.0f / 1024.0f) + 1e-6f); }
#define DPP_ADD(x, ctrl) x += __int_as_float(__builtin_amdgcn_update_dpp(0, __float_as_int(x), ctrl, 0xf, 0xf, true))
__device__ __forceinline__ float dpp_allreduce16(float x) { DPP_ADD(x, 0xB1); DPP_ADD(x, 0x4E); DPP_ADD(x, 0x141); DPP_ADD(x, 0x140); return x; }

constexpr int BM = 256, BK = 64, HALF = 128, HTB = HALF * BK * 2, NXCD = 8, WGM = 4;
__device__ __forceinline__ int lds_byte(int r, int c) { const int st = (r >> 4) * 2 + (c >> 5), rr = r & 15, cc = c & 31, ob = rr * 64 + cc * 2; return st * 1024 + (ob ^ (((ob >> 9) & 1) << 5)); }
__device__ __forceinline__ void stage_rc(int b, int& R, int& C) { const int st = b / 1024, sb = b % 1024, swz = sb ^ (((sb >> 9) & 1) << 5); R = (st >> 1) * 16 + swz / 64; C = (st & 1) * 32 + (swz % 64) / 2; }
__device__ __forceinline__ int perm32(int rho) { const int n = rho >> 4, i = rho & 15; return 8 * (i >> 2) + 4 * n + (i & 3); }

struct Unit { int pm, pn, ko; };
struct Gemm { const bf16_t* A; const bf16_t* Bt; int lda, ldb, K; };
struct StaticOrder {
    int nM, nN, nwg, G, c;
    __device__ void init(int nM_, int nN_, int G_, int c_) { nM = nM_; nN = nN_; nwg = nM * nN; G = G_; c = c_; }
    __device__ bool next(int i, Unit& u) const {
        const long L = (long)i * G + c; if (L >= nwg) return false;
        int wgid = (int)L; { const int q = nwg / NXCD, r = nwg % NXCD, xcd = wgid % NXCD, off = wgid / NXCD; wgid = (xcd < r ? xcd * (q + 1) : r * (q + 1) + (xcd - r) * q) + off; }
        const int nig = WGM * nN, gid = wgid / nig, fm = gid * WGM, gsz = (nM - fm) < WGM ? (nM - fm) : WGM;
        u.pm = fm + ((wgid % nig) % gsz); u.pn = (wgid % nig) / gsz; u.ko = 0; return true;
    }
};
struct SplitOrder {
    int nN, S, Kc, G, c;
    __device__ bool next(int i, Unit& u) const { const long L = (long)i * G + c; if (L >= (long)nN * S) return false; u.pm = 64; u.pn = (int)(L % nN); u.ko = (int)(L / nN) * Kc; return true; }
};
struct DiagOrder {
    int n, G, c;
    __device__ bool next(int i, Unit& u) const { const long L = (long)i * G + c; if (L >= n) return false; u.pm = (int)L; u.pn = (int)(L >> 2); u.ko = 0; return true; }
};

typedef f32x4 AccT[2][2][4][2];

template <class Epi, class Sched>
__device__ __forceinline__ void gemm_phase_acc(LAS unsigned char* lds, const Gemm g, const Sched& S, const Epi& E, AccT& acc, const bool zero) {
    int tid_ = threadIdx.x; asm volatile("" : "+v"(tid_));
    const int tid = tid_, wid = __builtin_amdgcn_readfirstlane(tid >> 6), lane = tid & 63, wr = wid >> 2, wc = wid & 3, fr = lane & 15, fq = lane >> 4;
    const int nt = g.K / BK;
    unsigned voffA[2], voffB[2];
#pragma unroll
    for (int i = 0; i < 2; ++i) { int R, C; stage_rc(tid * 16 + i * 8192, R, C); const int Rb = Epi::PERM ? ((R & ~31) + perm32(R & 31)) : R;
        voffA[i] = (unsigned)(R * g.lda + C) * 2u; voffB[i] = (unsigned)(Rb * g.ldb + C) * 2u; }
    const size_t kstep = (size_t)(BK * 2);
    const size_t hstepA = (size_t)HALF * g.lda * 2, hstepB = (size_t)HALF * g.ldb * 2;
    const size_t tstepA = 2 * hstepA, tstepB = 2 * hstepB;
    const unsigned ldsw = (unsigned)wid * 1024u;
    const int aoff = lds_byte(wr * 64 + fr, fq * 8), boff = lds_byte(wc * 32 + fr, fq * 8);
#define PG8_SA(b, h) (((b) * 2 + (h)) * HTB)
#define PG8_SB(b, h) ((4 + (b) * 2 + (h)) * HTB)
#define PG8_STAGE(bufoff, gbase, voff) do { _Pragma("unroll") for (int _i = 0; _i < 2; ++_i) \
        __builtin_amdgcn_global_load_lds((const unsigned*)((const char*)(gbase) + (voff)[_i]), (LAS unsigned*)(lds + (bufoff) + ldsw + _i * 8192), 16, 0, 0); } while (0)
#define PG8_LDA(dst, b, h) do { _Pragma("unroll") for (int m = 0; m < 4; ++m) _Pragma("unroll") for (int k = 0; k < 2; ++k) dst[m][k] = *(const LAS bf16x8*)(lds + PG8_SA(b, h) + aoff + m * 2048 + k * 1024); } while (0)
#define PG8_LDB(dst, b, h) do { _Pragma("unroll") for (int n = 0; n < 2; ++n) _Pragma("unroll") for (int k = 0; k < 2; ++k) dst[n][k] = *(const LAS bf16x8*)(lds + PG8_SB(b, h) + boff + n * 2048 + k * 1024); } while (0)
#define PG8_MMA(ai, bj, At, Bt) do { __builtin_amdgcn_s_setprio(1); _Pragma("unroll") for (int m = 0; m < 4; ++m) _Pragma("unroll") for (int n = 0; n < 2; ++n) _Pragma("unroll") for (int k = 0; k < 2; ++k) \
        acc[ai][bj][m][n] = __builtin_amdgcn_mfma_f32_16x16x32_bf16(Bt[n][k], At[m][k], acc[ai][bj][m][n], 0, 0, 0); __builtin_amdgcn_s_setprio(0); } while (0)
#define PG8_WAIT_V(n) asm volatile("s_waitcnt vmcnt(" #n ")" ::: "memory")
#define PG8_WAIT_L(n) asm volatile("s_waitcnt lgkmcnt(" #n ")" ::: "memory")
#define PG8_BAR __builtin_amdgcn_s_barrier()
#define PG8_SCHED __builtin_amdgcn_sched_barrier(0)
    Unit cur, nxt; int ui = 0;
    if (!S.next(0, cur)) return;
    if (zero) {
#pragma unroll
    for (int a = 0; a < 2; ++a)
#pragma unroll
        for (int b = 0; b < 2; ++b)
#pragma unroll
            for (int m = 0; m < 4; ++m)
#pragma unroll
                for (int n = 0; n < 2; ++n) acc[a][b][m][n] = (f32x4){0.f, 0.f, 0.f, 0.f};
    }
    bf16x8 At[4][2], B0[2][2], B1[2][2];
    const char* cA = (const char*)g.A + (size_t)cur.pm * tstepA + (size_t)cur.ko * 2; const char* cB = (const char*)g.Bt + (size_t)cur.pn * tstepB + (size_t)cur.ko * 2;
    PG8_STAGE(PG8_SB(0, 0), cB, voffB); PG8_STAGE(PG8_SA(0, 0), cA, voffA); PG8_STAGE(PG8_SB(0, 1), cB + hstepB, voffB); PG8_STAGE(PG8_SA(0, 1), cA + hstepA, voffA);
    if (wr == 1) PG8_BAR;
    PG8_WAIT_V(4); PG8_BAR;
    PG8_STAGE(PG8_SB(1, 0), cB + kstep, voffB); PG8_STAGE(PG8_SA(1, 0), cA + kstep, voffA); PG8_STAGE(PG8_SB(1, 1), cB + hstepB + kstep, voffB);
    PG8_WAIT_V(6); PG8_BAR;
#pragma nounroll
    for (;;) {
        const bool has_next = S.next(ui + 1, nxt);
        const char* nA = has_next ? (const char*)g.A + (size_t)nxt.pm * tstepA + (size_t)nxt.ko * 2 : cA; const char* nB = has_next ? (const char*)g.Bt + (size_t)nxt.pn * tstepB + (size_t)nxt.ko * 2 : cB;
#pragma nounroll
        for (int t = 0; t < nt; t += 2) {
            const bool last = (t == nt - 2);
            const char* a1 = cA + (size_t)(t + 1) * kstep;
            const char* a2 = last ? nA : cA + (size_t)(t + 2) * kstep; const char* b2 = last ? nB : cB + (size_t)(t + 2) * kstep;
            const char* a3 = a2 + kstep; const char* b3 = b2 + kstep;
            PG8_LDB(B0, 0, 0); PG8_SCHED; PG8_LDA(At, 0, 0); PG8_STAGE(PG8_SA(1, 1), a1 + hstepA, voffA);
            PG8_WAIT_L(8); PG8_BAR; PG8_WAIT_L(0); PG8_MMA(0, 0, At, B0); PG8_BAR; PG8_SCHED;
            PG8_LDB(B1, 0, 1); PG8_STAGE(PG8_SB(0, 0), b2, voffB);
            PG8_BAR; PG8_WAIT_L(0); PG8_MMA(0, 1, At, B1); PG8_BAR;
            PG8_LDA(At, 0, 1); PG8_STAGE(PG8_SA(0, 0), a2, voffA);
            PG8_BAR; PG8_WAIT_L(0); PG8_MMA(1, 0, At, B0); PG8_BAR; PG8_SCHED;
            PG8_STAGE(PG8_SB(0, 1), b2 + hstepB, voffB);
            PG8_WAIT_V(6); PG8_BAR; PG8_MMA(1, 1, At, B1); PG8_BAR;
            PG8_LDB(B0, 1, 0); PG8_SCHED; PG8_LDA(At, 1, 0); PG8_STAGE(PG8_SA(0, 1), a2 + hstepA, voffA);
            PG8_WAIT_L(8); PG8_BAR; PG8_WAIT_L(0); PG8_MMA(0, 0, At, B0); PG8_BAR; PG8_SCHED;
            PG8_LDB(B1, 1, 1); PG8_STAGE(PG8_SB(1, 0), b3, voffB);
            PG8_BAR; PG8_WAIT_L(0); PG8_MMA(0, 1, At, B1); PG8_BAR;
            PG8_LDA(At, 1, 1); PG8_STAGE(PG8_SA(1, 0), a3, voffA);
            PG8_BAR; PG8_WAIT_L(0); PG8_MMA(1, 0, At, B0); PG8_BAR; PG8_SCHED;
            PG8_STAGE(PG8_SB(1, 1), b3 + hstepB, voffB);
            PG8_WAIT_V(6); PG8_BAR; PG8_MMA(1, 1, At, B1); PG8_BAR;
        }
        if constexpr (!Epi::AFTER_DRAIN) E(acc, cur, wr, wc, fr, fq);
        if (!has_next) break;
#pragma unroll
        for (int a = 0; a < 2; ++a)
#pragma unroll
            for (int b = 0; b < 2; ++b)
#pragma unroll
                for (int m = 0; m < 4; ++m)
#pragma unroll
                    for (int n = 0; n < 2; ++n) acc[a][b][m][n] = (f32x4){0.f, 0.f, 0.f, 0.f};
        cur = nxt; cA = nA; cB = nB; ++ui;
    }
    PG8_WAIT_V(0);
    if (wr == 0) PG8_BAR;
    PG8_BAR;
    if constexpr (Epi::AFTER_DRAIN) E.fused(acc, cur, wr, wc, fr, fq, lds, wid, lane);
#undef PG8_SA
#undef PG8_SB
#undef PG8_STAGE
#undef PG8_LDA
#undef PG8_LDB
#undef PG8_MMA
#undef PG8_WAIT_V
#undef PG8_WAIT_L
#undef PG8_BAR
#undef PG8_SCHED
}
template <class Epi, class Sched>
__device__ __forceinline__ void gemm_phase(LAS unsigned char* lds, const Gemm g, const Sched& S, const Epi& E) { AccT acc; gemm_phase_acc(lds, g, S, E, acc, true); }

#define EPI_ROWS_BEGIN  _Pragma("unroll") for (int ai = 0; ai < 2; ++ai) { if (u.pm * BM + ai * HALF >= MV) continue; _Pragma("unroll") for (int m = 0; m < 4; ++m) { const int row = u.pm * BM + ai * HALF + wr * 64 + m * 16 + fr;
#define EPI_ROWS_END    asm volatile("" ::: "memory"); } }

struct EpiFfnUp {
    static constexpr bool PERM = true, AFTER_DRAIN = false;
    bf16_t* H; const float* rs; int is_ss;
    __device__ __forceinline__ void operator()(const AccT& acc, const Unit& u, int wr, int wc, int fr, int fq) const {
        const int j0 = u.pn * 128 + wc * 32 + 8 * fq;
        EPI_ROWS_BEGIN
            const float s = is_ss ? row_rs(rs, row) : rs[row];
            f32x4 h0, h1;
#pragma unroll
            for (int j = 0; j < 4; ++j) { h0[j] = siluf_(acc[ai][0][m][0][j] * s) * (acc[ai][1][m][0][j] * s); h1[j] = siluf_(acc[ai][0][m][1][j] * s) * (acc[ai][1][m][1][j] * s); }
            store8(H + (size_t)row * FF + j0, h0, h1);
        EPI_ROWS_END
    }
};
struct EpiResid {
    static constexpr bool PERM = false, AFTER_DRAIN = false;
    const bf16_t* xb; bf16_t* XH; float* SS; float alpha; int first;
    __device__ __forceinline__ void operator()(const AccT& acc, const Unit& u, int wr, int wc, int fr, int fq) const {
        const int col0 = u.pn * BM + wc * 32 + 4 * fq;
        EPI_ROWS_BEGIN
            const bf16_t* src = xb + (size_t)row * DM;
            bf16_t* xr = XH + (size_t)row * 2048 + 1024; float ssq = 0.f;
#pragma unroll
            for (int bj = 0; bj < 2; ++bj)
#pragma unroll
                for (int n = 0; n < 2; ++n) { const int c = col0 + bj * HALF + n * 16; const f32x4 b = load4bf(first ? src + c : xr + c); const f32x4 o = b + acc[ai][bj][m][n] * alpha;
                    store4bf(xr + c, o); ssq += (o[0] * o[0] + o[1] * o[1]) + (o[2] * o[2] + o[3] * o[3]); }
            ssq += __shfl_xor(ssq, 16); ssq += __shfl_xor(ssq, 32);
            if (fq == 0) SS[(size_t)row * 16 + u.pn * 4 + wc] = ssq;
        EPI_ROWS_END
    }
};
struct EpiWin {
    static constexpr bool PERM = true, AFTER_DRAIN = false;
    const float* SS; bf16_t* F; bf16_t* As5; float* Us; bf16_t* Gt;
    __device__ __forceinline__ void operator()(const AccT& acc, const Unit& u, int wr, int wc, int fr, int fq) const {
        const int c0b = u.pn * BM + wc * 32 + 8 * fq;
        EPI_ROWS_BEGIN
            const float s = row_rs(SS, row);
#pragma unroll
            for (int bj = 0; bj < 2; ++bj) { const int c0 = c0b + bj * HALF; f32x4 v0 = acc[ai][bj][m][0] * s, v1 = acc[ai][bj][m][1] * s;
                if (u.pn < 7) store8(F + (size_t)row * RC + c0, v0, v1);
                else if (u.pn < 9) { const int uc = c0 - RC;
                    if (row < MPROMPT) { const int g = uc >> 4, h0 = uc & 15, b = row >> 11, t = row & 2047, c = t >> 4, tl = t & 15;
                        store8(As5 + ((size_t)(g * 1024 + b * 128 + c)) * 384 + 128 + tl * 16 + h0, v0, v1); }
                    else { float* d = Us + (size_t)(row - MPROMPT) * 512 + uc; *(f32x4*)d = v0; *(f32x4*)(d + 4) = v1; } }
                else { const int gc = c0 - 2304;
#pragma unroll
                    for (int j = 0; j < 4; ++j) { v0[j] = sigmoidf_(v0[j]); v1[j] = sigmoidf_(v1[j]); }
                    store8(Gt + (size_t)row * 2048 + gc, v0, v1); } }
        EPI_ROWS_END
    }
};
struct EpiLora {
    static constexpr bool PERM = true, AFTER_DRAIN = false;
    bf16_t* LOwa; bf16_t* LOg;
    __device__ __forceinline__ void operator()(const AccT& acc, const Unit& u, int wr, int wc, int fr, int fq) const {
        const int c0b = u.pn * BM + wc * 32 + 8 * fq;
        EPI_ROWS_BEGIN
#pragma unroll
            for (int bj = 0; bj < 2; ++bj) { const int c0 = c0b + bj * HALF;
                if (u.pn < 4) store8(LOwa + (size_t)row * 1024 + c0, acc[ai][bj][m][0], acc[ai][bj][m][1]);
                else store8(LOg + (size_t)row * 512 + c0 - 1024, acc[ai][bj][m][0], acc[ai][bj][m][1]); }
        EPI_ROWS_END
    }
};
struct EpiS5a {
    static constexpr bool PERM = false, AFTER_DRAIN = false;
    float* E;
    __device__ __forceinline__ void operator()(const AccT& acc, const Unit& u, int wr, int wc, int fr, int fq) const {
        const int g = u.pn, n0 = wc * 32 + 4 * fq;
#pragma unroll
        for (int ai = 0; ai < 2; ++ai)
#pragma unroll
            for (int m = 0; m < 4; ++m) { const int mr = (u.pm & 3) * 256 + ai * HALF + wr * 64 + m * 16 + fr;
#pragma unroll
                for (int n = 0; n < 2; ++n) *(f32x4*)(E + ((size_t)(g * 1024 + mr)) * 128 + n0 + n * 16) = acc[ai][0][m][n]; }
    }
};
struct EpiS5b {
    static constexpr bool PERM = true, AFTER_DRAIN = false;
    const bf16_t* As5; const float* Dsk; bf16_t* Z;
    __device__ __forceinline__ void operator()(const AccT& acc, const Unit& u, int wr, int wc, int fr, int fq) const {
        const int g = u.pn;
#pragma unroll
        for (int ai = 0; ai < 2; ++ai)
#pragma unroll
            for (int m = 0; m < 4; ++m) { const int mr = (u.pm & 3) * 256 + ai * HALF + wr * 64 + m * 16 + fr; const int b = mr >> 7, c = mr & 127;
#pragma unroll
                for (int bj = 0; bj < 2; ++bj) { const int n0 = bj * HALF + wc * 32 + 8 * fq, tl = n0 >> 4, h0 = n0 & 15; const int col = g * 16 + h0;
                    f32x4 u0, u1; load8(As5 + ((size_t)(g * 1024 + mr)) * 384 + 128 + n0, u0, u1);
                    const f32x4 d0 = *(const f32x4*)(Dsk + col), d1 = *(const f32x4*)(Dsk + col + 4);
                    f32x4 y0 = acc[ai][bj][m][0] + d0 * u0, y1 = acc[ai][bj][m][1] + d1 * u1;
#pragma unroll
                    for (int j = 0; j < 4; ++j) { y0[j] = geluf_(y0[j]); y1[j] = geluf_(y1[j]); }
                    store8(Z + ((size_t)(b * 2048 + c * 16 + tl)) * 512 + col, y0, y1); }
                asm volatile("" ::: "memory"); }
    }
};
struct EpiGlu {
    static constexpr bool PERM = true, AFTER_DRAIN = false;
    const bf16_t* Z; bf16_t* YAB;
    __device__ __forceinline__ void operator()(const AccT& acc, const Unit& u, int wr, int wc, int fr, int fq) const {
        const int c0b = u.pn * BM + wc * 32 + 8 * fq;
        EPI_ROWS_BEGIN
#pragma unroll
            for (int bj = 0; bj < 2; ++bj) { const int c0 = c0b + bj * HALF; f32x4 z0, z1; load8(Z + (size_t)row * 512 + c0, z0, z1);
                f32x4 v0 = acc[ai][bj][m][0], v1 = acc[ai][bj][m][1];
#pragma unroll
                for (int j = 0; j < 4; ++j) { v0[j] = z0[j] * sigmoidf_(v0[j]); v1[j] = z1[j] * sigmoidf_(v1[j]); }
                store8(YAB + (size_t)row * 1024 + 512 + c0, v0, v1); }
        EPI_ROWS_END
    }
};
struct EpiGateRatio {
    static constexpr bool PERM = true, AFTER_DRAIN = false;
    const bf16_t* Gt;
    __device__ __forceinline__ void operator()(AccT& acc, const Unit& u, int wr, int wc, int fr, int fq) const {
        const int c0b = u.pn * BM + wc * 32 + 8 * fq;
        EPI_ROWS_BEGIN
#pragma unroll
            for (int bj = 0; bj < 2; ++bj) { const int c0 = c0b + bj * HALF; f32x4 a0, a1, b0, b1; load8(Gt + (size_t)row * 2048 + c0, a0, a1); load8(Gt + (size_t)row * 2048 + 1024 + c0, b0, b1);
#pragma unroll
                for (int j = 0; j < 4; ++j) { acc[ai][bj][m][0][j] *= a0[j] * __builtin_amdgcn_rcpf(fmaxf(b0[j], 1e-30f)); acc[ai][bj][m][1][j] *= a1[j] * __builtin_amdgcn_rcpf(fmaxf(b1[j], 1e-30f)); } }
        EPI_ROWS_END
    }
};
struct EpiGateOut {
    static constexpr bool PERM = true, AFTER_DRAIN = false;
    const bf16_t* Gt; bf16_t* Mg;
    __device__ __forceinline__ void operator()(const AccT& acc, const Unit& u, int wr, int wc, int fr, int fq) const {
        const int c0b = u.pn * BM + wc * 32 + 8 * fq;
        EPI_ROWS_BEGIN
#pragma unroll
            for (int bj = 0; bj < 2; ++bj) { const int c0 = c0b + bj * HALF; f32x4 b0, b1; load8(Gt + (size_t)row * 2048 + 1024 + c0, b0, b1);
                store8(Mg + (size_t)row * 1024 + c0, acc[ai][bj][m][0] * b0, acc[ai][bj][m][1] * b1); }
        EPI_ROWS_END
    }
};
struct EpiGate {
    static constexpr bool PERM = true, AFTER_DRAIN = false;
    const bf16_t* Gt; bf16_t* T; bf16_t* Mg; int second;
    __device__ __forceinline__ void operator()(const AccT& acc, const Unit& u, int wr, int wc, int fr, int fq) const {
        const int c0b = u.pn * BM + wc * 32 + 8 * fq;
        EPI_ROWS_BEGIN
#pragma unroll
            for (int bj = 0; bj < 2; ++bj) { const int c0 = c0b + bj * HALF; f32x4 g0, g1; load8(Gt + (size_t)row * 2048 + (second ? 1024 : 0) + c0, g0, g1);
                f32x4 v0 = acc[ai][bj][m][0] * g0, v1 = acc[ai][bj][m][1] * g1;
                if (second) { f32x4 t0, t1; load8(T + (size_t)row * 1024 + c0, t0, t1); v0 += t0; v1 += t1; store8(Mg + (size_t)row * 1024 + c0, v0, v1); }
                else store8(T + (size_t)row * 1024 + c0, v0, v1); }
        EPI_ROWS_END
    }
};

struct EpiFinal {
    static constexpr bool PERM = false, AFTER_DRAIN = true;
    float* X; const float* gfin; float* slots; unsigned* pcnt;
    __device__ __forceinline__ void fused(AccT& acc, const Unit& u, int wr, int wc, int fr, int fq, LAS unsigned char* lds, int wid, int lane) const {
        LAS float* Pp = (LAS float*)lds;
        LAS float* Sr = (LAS float*)(lds + 4096);
        const int col0 = u.pn * BM + wc * 32 + 4 * fq, tid = threadIdx.x;
#pragma unroll
        for (int ai = 0; ai < 2; ++ai)
#pragma unroll
            for (int m = 0; m < 4; ++m) { const int rl = ai * HALF + wr * 64 + m * 16 + fr; const bf16_t* src = (const bf16_t*)X + (size_t)(u.pm * BM + rl) * 2048 + 1024 + col0; float ssq = 0.f;
#pragma unroll
                for (int bj = 0; bj < 2; ++bj)
#pragma unroll
                    for (int n = 0; n < 2; ++n) { const f32x4 o = load4bf(src + bj * HALF + n * 16) + acc[ai][bj][m][n] * 0.5f; acc[ai][bj][m][n] = o; ssq += (o[0] * o[0] + o[1] * o[1]) + (o[2] * o[2] + o[3] * o[3]); }
                ssq += __shfl_xor(ssq, 16); ssq += __shfl_xor(ssq, 32);
                if (fq == 0) Pp[rl * 4 + wc] = ssq;
                asm volatile("" ::: "memory"); }
        __syncthreads();
        if (tid < 256) { const float sblk = (Pp[tid * 4] + Pp[tid * 4 + 1]) + (Pp[tid * 4 + 2] + Pp[tid * 4 + 3]);
            __hip_atomic_store(slots + ((size_t)(u.pm * BM + tid)) * 4 + u.pn, sblk, __ATOMIC_RELAXED, __HIP_MEMORY_SCOPE_AGENT); }
        asm volatile("s_waitcnt vmcnt(0)" ::: "memory");
        __syncthreads();
        if (tid == 0) { __hip_atomic_fetch_add(pcnt + 64 * u.pm, 1u, __ATOMIC_RELAXED, __HIP_MEMORY_SCOPE_AGENT);
            unsigned spins = 0; while (__hip_atomic_load(pcnt + 64 * u.pm, __ATOMIC_RELAXED, __HIP_MEMORY_SCOPE_AGENT) < 4u && ++spins < (1u << 22)) __builtin_amdgcn_s_sleep(2);
            __builtin_amdgcn_fence(__ATOMIC_ACQUIRE, "agent"); asm volatile("s_waitcnt vmcnt(0)" ::: "memory"); }
        __syncthreads();
        if (tid < 256) { const float* sl = slots + ((size_t)(u.pm * BM + tid)) * 4; float t = 0.f;
#pragma unroll
            for (int k = 0; k < 4; ++k) t += __hip_atomic_load(sl + k, __ATOMIC_RELAXED, __HIP_MEMORY_SCOPE_AGENT);
            Sr[tid] = rsqrtf(t * (1.0f / 1024.0f) + 1e-6f); }
        __syncthreads();
#pragma unroll
        for (int ai = 0; ai < 2; ++ai)
#pragma unroll
            for (int m = 0; m < 4; ++m) { const int rl = ai * HALF + wr * 64 + m * 16 + fr; const float sc = Sr[rl]; float* dst = X + (size_t)(u.pm * BM + rl) * DM + col0;
#pragma unroll
                for (int bj = 0; bj < 2; ++bj)
#pragma unroll
                    for (int n = 0; n < 2; ++n) { const f32x4 gf = *(const f32x4*)(gfin + col0 + bj * HALF + n * 16); *(f32x4*)(dst + bj * HALF + n * 16) = acc[ai][bj][m][n] * sc * gf; }
                asm volatile("" ::: "memory"); }
        __syncthreads();
    }
};
struct EpiSlab {
    static constexpr bool PERM = false, AFTER_DRAIN = false;
    float* slab; int Kc;
    __device__ __forceinline__ void operator()(const AccT& acc, const Unit& u, int wr, int wc, int fr, int fq) const {
        const int col0 = u.pn * BM + wc * 32 + 4 * fq, slice = u.ko / Kc;
        EPI_ROWS_BEGIN
            float* d = slab + ((size_t)(slice * 128 + (row - MPROMPT))) * 1024 + col0;
#pragma unroll
            for (int bj = 0; bj < 2; ++bj)
#pragma unroll
                for (int n = 0; n < 2; ++n) *(f32x4*)(d + bj * HALF + n * 16) = acc[ai][bj][m][n];
        EPI_ROWS_END
    }
};

__device__ __forceinline__ void conv_matrix(LAS float* tile, const float* src, int K, int N, bf16_t* dst, int ldd, int nmul, int nadd, const float* scale, int bi, int nb) {
    const int t = threadIdx.x, tk = K >> 6, tn = N >> 6, nt = tk * tn;
    const int kr = t >> 3, nc = (t & 7) * 8;
    for (int id0 = bi; id0 < nt; id0 += 4 * nb) {
        f32x4 a[4], b[4]; float sc[4];
#pragma unroll
        for (int q = 0; q < 4; ++q) { const int id = id0 + q * nb;
            if (id < nt) { const int k0 = (id / tn) << 6, n0 = (id % tn) << 6; const float* sp = src + (size_t)(k0 + kr) * N + n0 + nc; a[q] = *(const f32x4*)sp; b[q] = *(const f32x4*)(sp + 4); sc[q] = scale ? scale[k0 + kr] : 1.0f; }
            else { a[q] = (f32x4){0.f, 0.f, 0.f, 0.f}; b[q] = a[q]; sc[q] = 0.f; } }
#pragma unroll
        for (int q = 0; q < 4; ++q) { LAS float* tq = tile + q * (64 * 65);
#pragma unroll
            for (int i = 0; i < 4; ++i) { tq[kr * 65 + nc + i] = a[q][i] * sc[q]; tq[kr * 65 + nc + 4 + i] = b[q][i] * sc[q]; } }
        __syncthreads();
#pragma unroll
        for (int q = 0; q < 4; ++q) { const int id = id0 + q * nb;
            if (id < nt) { const int k0 = (id / tn) << 6, n0 = (id % tn) << 6; const LAS float* tq = tile + q * (64 * 65); const int nr = t >> 3, kc = (t & 7) * 8; f32x4 x, y;
#pragma unroll
                for (int i = 0; i < 4; ++i) { x[i] = tq[(kc + i) * 65 + nr]; y[i] = tq[(kc + 4 + i) * 65 + nr]; }
                const int nn = n0 + nr; const int drow = nmul == 2 ? (((nn >> 7) << 8) + (nn & 127) + nadd * 128) : nn;
                store8(dst + (size_t)drow * ldd + k0 + kc, x, y); } }
        __syncthreads();
    }
}

__device__ __forceinline__ void conv_job(const Params& P, LAS float* tile, int j, int bi, int nb) {
    unsigned char* ws = P.ws; const float* src; const float* scale = nullptr; int K, N, ldd, nmul = 1, nadd = 0; bf16_t* dst;
    switch (j) {
        case 0: src = P.in[7]; K = 1024; N = FF; dst = (bf16_t*)(ws + WS_WFFN); ldd = 1024; nmul = 2; scale = P.in[6]; break;
        case 1: src = P.in[8]; K = 1024; N = FF; dst = (bf16_t*)(ws + WS_WFFN); ldd = 1024; nmul = 2; nadd = 1; scale = P.in[6]; break;
        case 2: src = P.in[9]; K = FF; N = 1024; dst = (bf16_t*)(ws + WS_WDT); ldd = FF; break;
        case 3: src = P.in[11]; K = 1024; N = 4352; dst = (bf16_t*)(ws + WS_WIN); ldd = 1024; scale = P.in[10]; break;
        case 4: src = P.in[31]; K = 512; N = 512; dst = (bf16_t*)(ws + WS_WGLU); ldd = 512; break;
        case 5: src = P.in[32]; K = 512; N = 1024; dst = (bf16_t*)(ws + WS_WA); ldd = 512; break;
        case 6: src = P.in[33]; K = 512; N = 1024; dst = (bf16_t*)(ws + WS_WB); ldd = 512; break;
        case 7: src = P.in[34]; K = 1024; N = 1024; dst = (bf16_t*)(ws + WS_WOUT); ldd = 1024; break;
        case 8: src = P.in[36]; K = 1024; N = FF; dst = (bf16_t*)(ws + WS_WFFN); ldd = 1024; nmul = 2; scale = P.in[35]; break;
        case 9: src = P.in[37]; K = 1024; N = FF; dst = (bf16_t*)(ws + WS_WFFN); ldd = 1024; nmul = 2; nadd = 1; scale = P.in[35]; break;
        default: src = P.in[38]; K = FF; N = 1024; dst = (bf16_t*)(ws + WS_WDT); ldd = FF; break;
    }
    conv_matrix(tile, src, K, N, dst, ldd, nmul, nadd, scale, bi, nb);
}

__device__ __forceinline__ void s5_pow(float lr, float li, float dt, float j, float& ar, float& ai) { const float mg = __expf(lr * dt * j), ang = li * dt * j; ar = mg * cosf(ang); ai = mg * sinf(ang); }
__device__ __forceinline__ void s5_q(float lr, float li, float dt, float& qr, float& qi) { float ar, ai; s5_pow(lr, li, dt, 1.0f, ar, ai); const float den = lr * lr + li * li; qr = ((ar - 1.0f) * lr + ai * li) / den; qi = (ai * lr - (ar - 1.0f) * li) / den; }

__device__ __forceinline__ void phase_prep(const Params& P, LAS unsigned char* lds) {
    unsigned char* ws = P.ws; const int tid = threadIdx.x, lane = tid & 63, wave = tid >> 6;
    const size_t gtid = (size_t)blockIdx.x * NTHR + tid, gthreads = (size_t)gridDim.x * NTHR;
    { bf16_t* xb = (bf16_t*)(ws + WS_RX); float* rs1 = (float*)(ws + WS_RS1);
      for (int row0 = blockIdx.x * 8 + wave; row0 < MP; row0 += 2 * gridDim.x * 8) {
          f32x4 v[2][4];
#pragma unroll
          for (int q = 0; q < 2; ++q) { const int row = row0 + q * gridDim.x * 8;
              if (row < MV) { const float* src = row < MPROMPT ? P.in[0] + (size_t)row * DM : P.in[1] + (size_t)(row - MPROMPT) * DM;
#pragma unroll
                  for (int i = 0; i < 4; ++i) v[q][i] = *(const f32x4*)(src + i * 256 + lane * 4); }
              else {
#pragma unroll
                  for (int i = 0; i < 4; ++i) v[q][i] = (f32x4){0.f, 0.f, 0.f, 0.f}; } }
#pragma unroll
          for (int q = 0; q < 2; ++q) { const int row = row0 + q * gridDim.x * 8; if (row >= MP) continue; float ssq = 0.f;
#pragma unroll
              for (int i = 0; i < 4; ++i) { ssq += (v[q][i][0] * v[q][i][0] + v[q][i][1] * v[q][i][1]) + (v[q][i][2] * v[q][i][2] + v[q][i][3] * v[q][i][3]); store4bf(xb + (size_t)row * DM + i * 256 + lane * 4, v[q][i]); }
              ssq = red64(ssq);
              if (lane == 0) rs1[row] = row < MV ? rsqrtf(ssq * (1.0f / 1024.0f) + 1e-6f) : 0.f; } } }
    LAS float* tile = (LAS float*)lds;
    for (int j = 0; j < 3; ++j) conv_job(P, tile, j, blockIdx.x, gridDim.x);
}

__device__ __forceinline__ void phase_prep2(const Params& P, LAS unsigned char* lds, int blk_i, int blk_n) {
    unsigned char* ws = P.ws; const int tid = threadIdx.x, lane = tid & 63, wave = tid >> 6;
    const size_t gtid = (size_t)blk_i * NTHR + tid, gthreads = (size_t)blk_n * NTHR;
    LAS float* tile = (LAS float*)lds;
    { bf16_t* wl = (bf16_t*)(ws + WS_WL);
      for (size_t i = gtid; i < (size_t)1536 * 32; i += gthreads) { const int n = (int)(i >> 5), k0 = (int)(i & 31) * 8; f32x4 a = {0.f, 0.f, 0.f, 0.f}, b = a;
          if (n < 512) { if (k0 < 64) { for (int j = 0; j < 4; ++j) { a[j] = P.in[14][(size_t)(k0 + j) * 512 + n]; b[j] = P.in[14][(size_t)(k0 + 4 + j) * 512 + n]; } } }
          else if (n < 1024) { if (k0 >= 64 && k0 < 128) { for (int j = 0; j < 4; ++j) { a[j] = P.in[16][(size_t)(k0 - 64 + j) * 512 + n - 512]; b[j] = P.in[16][(size_t)(k0 - 60 + j) * 512 + n - 512]; } } }
          else { if (k0 >= 128) { for (int j = 0; j < 4; ++j) { a[j] = P.in[17][(size_t)(k0 - 128 + j) * 512 + n - 1024]; b[j] = P.in[17][(size_t)(k0 - 124 + j) * 512 + n - 1024]; } } }
          store8(wl + (size_t)n * 256 + k0, a, b); } }
    const float* Are = P.in[23]; const float* Aim = P.in[24]; const float* ldt = P.in[25]; const float* Bre = P.in[26]; const float* Bim = P.in[27]; const float* Cre = P.in[28]; const float* Cim = P.in[29];
    { float* abar = (float*)(ws + WS_ABAR); float* abar16 = (float*)(ws + WS_ABAR16); float* bbt = (float*)(ws + WS_BBT);
      for (size_t i = gtid; i < 2048; i += gthreads) { const int g = (int)(i >> 6); const float dt = __expf(ldt[g]), lr = Are[i], li = Aim[i]; float ar, ai; s5_pow(lr, li, dt, 1.0f, ar, ai); abar[2 * i] = ar; abar[2 * i + 1] = ai;
          s5_pow(lr, li, dt, 16.0f, ar, ai); abar16[2 * i] = ar; abar16[2 * i + 1] = ai; float qr, qi; s5_q(lr, li, dt, qr, qi);
          for (int h = 0; h < 16; ++h) { const float br = Bre[i * 16 + h], bi = Bim[i * 16 + h]; bbt[(i * 16 + h) * 2] = qr * br - qi * bi; bbt[(i * 16 + h) * 2 + 1] = qr * bi + qi * br; } } }
    { bf16_t* w1 = (bf16_t*)(ws + WS_S5W1);
      for (size_t i = gtid; i < (size_t)32 * 128 * 16; i += gthreads) { const int s = (int)(i & 15), n = (int)((i >> 4) & 127), g = (int)(i >> 11); const int p = n & 63, im = n >> 6; const int gp = g * 64 + p;
          const float dt = __expf(ldt[g]), lr = Are[gp], li = Aim[gp]; float ar, ai, qr, qi; s5_pow(lr, li, dt, (float)(15 - s), ar, ai); s5_q(lr, li, dt, qr, qi);
          f32x4 o[4];
#pragma unroll
          for (int h = 0; h < 16; ++h) { const float br = Bre[gp * 16 + h], bi = Bim[gp * 16 + h]; const float bbr = qr * br - qi * bi, bbi = qr * bi + qi * br; o[h >> 2][h & 3] = im ? (ar * bbi + ai * bbr) : (ar * bbr - ai * bbi); }
          bf16_t* d = w1 + ((size_t)(g * 256 + n)) * 256 + s * 16; store8(d, o[0], o[1]); store8(d + 8, o[2], o[3]); }
      for (size_t i = gtid; i < (size_t)32 * 128 * 32; i += gthreads) { const int k8 = (int)(i & 31), n = 128 + (int)((i >> 5) & 127), g = (int)(i >> 12); *(u32x4*)(w1 + ((size_t)(g * 256 + n)) * 256 + k8 * 8) = (u32x4){0u, 0u, 0u, 0u}; } }
    { bf16_t* w2 = (bf16_t*)(ws + WS_S5W2);
      for (size_t i = gtid; i < (size_t)32 * 16 * 64; i += gthreads) { const int p = (int)(i & 63), tl = (int)((i >> 6) & 15), g = (int)(i >> 10); const int gp = g * 64 + p;
          const float dt = __expf(ldt[g]); float ar, ai; s5_pow(Are[gp], Aim[gp], dt, (float)(tl + 1), ar, ai);
          for (int h = 0; h < 16; ++h) { const float cr = Cre[(g * 16 + h) * 64 + p], ci = Cim[(g * 16 + h) * 64 + p]; bf16_t* d = w2 + ((size_t)(g * 256 + tl * 16 + h)) * 384;
              d[p] = (bf16_t)(cvt_pk_bf16(cr * ar - ci * ai, 0.f) & 0xffffu); d[64 + p] = (bf16_t)(cvt_pk_bf16(-cr * ai - ci * ar, 0.f) & 0xffffu); } } }
    { float* kt = (float*)(ws + WS_KT);
      for (int task = blk_i * 8 + wave; task < 32 * 16 * 16; task += blk_n * 8) { const int hp = task & 15, j = (task >> 4) & 15, g = task >> 8; const int gp = g * 64 + lane;
          const float dt = __expf(ldt[g]), lr = Are[gp], li = Aim[gp]; float ar, ai, qr, qi; s5_pow(lr, li, dt, (float)j, ar, ai); s5_q(lr, li, dt, qr, qi);
          const float br = Bre[gp * 16 + hp], bi = Bim[gp * 16 + hp]; const float bbr = qr * br - qi * bi, bbi = qr * bi + qi * br; const float xr = ar * bbr - ai * bbi, xi = ar * bbi + ai * bbr;
          float mine = 0.f;
          for (int h = 0; h < 16; ++h) { float v = Cre[(g * 16 + h) * 64 + lane] * xr - Cim[(g * 16 + h) * 64 + lane] * xi; v = red64(v); if (lane == h) mine = v; }
          if (lane < 16) kt[((g * 16 + j) * 16 + lane) * 16 + hp] = mine; } }
}

__device__ __forceinline__ void phase_mix(const Params& P) {
    unsigned char* ws = P.ws; const size_t gtid = (size_t)blockIdx.x * NTHR + threadIdx.x, gthreads = (size_t)gridDim.x * NTHR;
    const bf16_t* F = (const bf16_t*)(ws + WS_RH + RH_F); bf16_t* Lin = (bf16_t*)(ws + WS_RH + RH_LIN); const float* mu = P.in[12]; const float* sshift = P.in[2];
    for (size_t i = gtid; i < (size_t)MV * 32; i += gthreads) { const int row = (int)(i >> 5), ch = (int)(i & 31), col = 1536 + ch * 8;
        f32x4 f0, f1, p0, p1; load8(F + (size_t)row * RC + col, f0, f1);
        if (row < MPROMPT) { if ((row & 2047) > 0) load8(F + (size_t)(row - 1) * RC + col, p0, p1); else { p0 = (f32x4){0.f, 0.f, 0.f, 0.f}; p1 = p0; } }
        else { const float* s = sshift + (size_t)(row - MPROMPT) * RC + col; p0 = *(const f32x4*)s; p1 = *(const f32x4*)(s + 4); }
        const f32x4 m0 = *(const f32x4*)(mu + col), m1 = *(const f32x4*)(mu + col + 4);
        f0 = f0 + m0 * (p0 - f0); f1 = f1 + m1 * (p1 - f1);
        if (ch < 8) {
#pragma unroll
            for (int j = 0; j < 4; ++j) { f0[j] = tanhf_(f0[j]); f1[j] = tanhf_(f1[j]); } }
        else if (ch >= 16) {
#pragma unroll
            for (int j = 0; j < 4; ++j) { f0[j] = sigmoidf_(f0[j]); f1[j] = sigmoidf_(f1[j]); } }
        store8(Lin + (size_t)row * 256 + ch * 8, f0, f1); }
    for (size_t i = gtid; i < (size_t)136 * 224; i += gthreads) { const int r = (int)(i / 224), c8 = (int)(i % 224) * 8; const int row = r < 8 ? r * 2048 + 2047 : MPROMPT + (r - 8);
        f32x4 a, b; load8(F + (size_t)row * RC + c8, a, b); float* d = P.out + (r < 8 ? O_SHP + (size_t)r * RC : O_SHS + (size_t)(r - 8) * RC) + c8; *(f32x4*)d = a; *(f32x4*)(d + 4) = b; }
    { bf16_t* w2 = (bf16_t*)(ws + WS_S5W2); const float* kt = (const float*)(ws + WS_KT);
      for (size_t i = gtid; i < (size_t)32 * 256 * 32; i += gthreads) { const int k8 = (int)(i & 31), n = (int)((i >> 5) & 255), g = (int)(i >> 13); const int tl = n >> 4, h = n & 15, s = k8 >> 1, hp0 = (k8 & 1) * 8;
          f32x4 a = {0.f, 0.f, 0.f, 0.f}, b = a;
          if (s <= tl) { const float* src = kt + ((size_t)((g * 16 + (tl - s)) * 16 + h)) * 16 + hp0; a = *(const f32x4*)src; b = *(const f32x4*)(src + 4); }
          store8(w2 + ((size_t)(g * 256 + n)) * 384 + 128 + k8 * 8, a, b); } }
}

__device__ __forceinline__ void phase_carry(const Params& P, int b, int g, int p) {
    unsigned char* ws = P.ws;
    const float* E = P.out + O_WKVS; bf16_t* As5 = (bf16_t*)(ws + WS_RH + RH_AS5); const float* a16 = (const float*)(ws + WS_ABAR16);
    const float ar = a16[(g * 64 + p) * 2], ai = a16[(g * 64 + p) * 2 + 1];
    float xr = 0.f, xi = 0.f; const size_t base = (size_t)(g * 1024 + b * 128);
    for (int c0 = 0; c0 < 128; c0 += 32) {
        float er[32], ei[32];
#pragma unroll
        for (int j = 0; j < 32; ++j) { er[j] = E[(base + c0 + j) * 128 + p]; ei[j] = E[(base + c0 + j) * 128 + 64 + p]; }
#pragma unroll
        for (int j = 0; j < 32; ++j) { bf16_t* d = As5 + (base + c0 + j) * 384; d[p] = (bf16_t)(cvt_pk_bf16(xr, 0.f) & 0xffffu); d[64 + p] = (bf16_t)(cvt_pk_bf16(xi, 0.f) & 0xffffu);
            const float nr = ar * xr - ai * xi + er[j], ni = ar * xi + ai * xr + ei[j]; xr = nr; xi = ni; }
    }
    P.out[O_S5RP + (size_t)(b * 32 + g) * 64 + p] = xr; P.out[O_S5IP + (size_t)(b * 32 + g) * 64 + p] = xi;
}

constexpr int REC = 388;
struct PrepC { f32x4 mur, muk, muv, w0, a0, kk, ka, rk; };
__device__ __forceinline__ void load_prepc(PrepC& c, const Params& P, int h, int l16) { const int ch = h * 64 + l16 * 4;
    c.mur = *(const f32x4*)(P.in[12] + ch); c.muk = *(const f32x4*)(P.in[12] + 512 + ch); c.muv = *(const f32x4*)(P.in[12] + 1024 + ch);
    c.w0 = *(const f32x4*)(P.in[13] + ch); c.a0 = *(const f32x4*)(P.in[15] + ch); c.kk = *(const f32x4*)(P.in[18] + ch); c.ka = *(const f32x4*)(P.in[19] + ch); c.rk = *(const f32x4*)(P.in[20] + ch); }
__device__ __forceinline__ float prep_compute(const PrepC& c, f32x4 fr, f32x4 fk, f32x4 fv, f32x4 pr, f32x4 pk, f32x4 pv, f32x4 wpre, f32x4 apre, LAS float* rec, int l16) {
    const f32x4 r = fr + c.mur * (pr - fr), k = fk + c.muk * (pk - fk), v = fv + c.muv * (pv - fv);
    f32x4 w, a, kk, kp, b, wr;
#pragma unroll
    for (int i = 0; i < 4; ++i) { w[i] = __expf(-0.60653065971f * sigmoidf_(c.w0[i] + wpre[i])); a[i] = sigmoidf_(c.a0[i] + apre[i]); kk[i] = k[i] * c.kk[i]; }
    float n2 = (kk[0] * kk[0] + kk[1] * kk[1]) + (kk[2] * kk[2] + kk[3] * kk[3]); n2 = red16(n2);
    const float inv = 1.0f / fmaxf(sqrtf(n2), 1e-12f);
    float br = 0.f, kr = 0.f, bon = 0.f;
#pragma unroll
    for (int i = 0; i < 4; ++i) { kk[i] *= inv; kp[i] = k[i] * (1.0f + (a[i] - 1.0f) * c.ka[i]); b[i] = kk[i] * a[i]; wr[i] = w[i] * r[i]; br += b[i] * r[i]; kr += kp[i] * r[i]; bon += r[i] * kp[i] * c.rk[i]; }
    br = red16(br); kr = red16(kr); bon = red16(bon);
    *(LAS f32x4*)(rec + l16 * 4) = -kk; *(LAS f32x4*)(rec + 64 + l16 * 4) = wr; *(LAS f32x4*)(rec + 128 + l16 * 4) = w; *(LAS f32x4*)(rec + 192 + l16 * 4) = b; *(LAS f32x4*)(rec + 256 + l16 * 4) = kp; *(LAS f32x4*)(rec + 320 + l16 * 4) = v;
    if (l16 == 0) { rec[384] = br; rec[385] = kr; }
    return bon;
}

constexpr int CT = 32;
__device__ __forceinline__ void rwkv_prompt(const Params& P, LAS unsigned char* lds, int hd, int quarter) {
    unsigned char* ws = P.ws; const int tid = threadIdx.x, lane = tid & 63, wave = __builtin_amdgcn_readfirstlane(tid >> 6);
    const int b = hd >> 3, h = hd & 7;
    const bf16_t* F = (const bf16_t*)(ws + WS_RH + RH_F); const bf16_t* LOwa = (const bf16_t*)(ws + WS_RX); bf16_t* O = (bf16_t*)(ws + WS_RH + RH_AS5); float* BON = (float*)(ws + WS_BONUS);
    LAS float* buf = (LAS float*)lds;
    constexpr int NCH = 2048 / CT;
    if (wave >= 4) {
        const int ptid = tid - 256, l16 = ptid & 15, psub = ptid >> 4, ch = h * 64 + l16 * 4;
        PrepC pc; load_prepc(pc, P, h, l16);
        u32x2 raw[2][8];
        auto issue = [&](int c) {
#pragma unroll
            for (int j = 0; j < 2; ++j) { const int ps = psub + 16 * j; const size_t row = (size_t)b * 2048 + c * CT + ps; const bf16_t* f = F + row * RC + ch; const bf16_t* l = LOwa + row * 1024 + ch;
                raw[j][0] = *(const u32x2*)f; raw[j][1] = *(const u32x2*)(f + 512); raw[j][2] = *(const u32x2*)(f + 1024);
                if (c * CT + ps > 0) { raw[j][3] = *(const u32x2*)(f - RC); raw[j][4] = *(const u32x2*)(f - RC + 512); raw[j][5] = *(const u32x2*)(f - RC + 1024); } else { raw[j][3] = (u32x2){0u, 0u}; raw[j][4] = raw[j][3]; raw[j][5] = raw[j][3]; }
                raw[j][6] = *(const u32x2*)l; raw[j][7] = *(const u32x2*)(l + 512); } };
        auto cv = [](u32x2 w) { return (f32x4){bf_lo(w.x), bf_hi(w.x), bf_lo(w.y), bf_hi(w.y)}; };
        issue(0);
        for (int c = 0; c < NCH; ++c) {
            LAS float* cb = buf + (c & 1) * CT * REC;
#pragma unroll
            for (int j = 0; j < 2; ++j) { const int ps = psub + 16 * j; const size_t row = (size_t)b * 2048 + c * CT + ps;
                const float bon = prep_compute(pc, cv(raw[j][0]), cv(raw[j][1]), cv(raw[j][2]), cv(raw[j][3]), cv(raw[j][4]), cv(raw[j][5]), cv(raw[j][6]), cv(raw[j][7]), cb + ps * REC, l16);
                if (quarter == 0 && l16 == 0) BON[row * 8 + h] = bon; }
            if (c + 1 < NCH) issue(c + 1);
            __syncthreads();
        }
        __syncthreads();
    } else {
        const int rg = lane >> 4, kq = lane & 15, myrow = quarter * 16 + wave * 4 + rg;
        f32x4 S = {0.f, 0.f, 0.f, 0.f};
        __builtin_amdgcn_s_setprio(3);
        __syncthreads();
        for (int c = 0; c < NCH; ++c) {
            const LAS float* rec = buf + (c & 1) * CT * REC;
            f32x4 nkk = *(const LAS f32x4*)(rec + kq * 4), wr4 = *(const LAS f32x4*)(rec + 64 + kq * 4), w4 = *(const LAS f32x4*)(rec + 128 + kq * 4), b4 = *(const LAS f32x4*)(rec + 192 + kq * 4), kp4 = *(const LAS f32x4*)(rec + 256 + kq * 4);
            float vv = rec[320 + myrow]; f32x2 bk = *(const LAS f32x2*)(rec + 384);
            bf16_t* op = O + ((size_t)b * 2048 + c * CT + kq) * 512 + h * 64 + myrow;
            f32x2 S01 = {S[0], S[1]}, S23 = {S[2], S[3]};
#pragma unroll 1
            for (int s16 = 0; s16 < CT; s16 += 16) {
                float osel = 0.f;
#pragma unroll
                for (int u = 0; u < 16; ++u) {
                    const LAS float* rn = rec + (s16 + u + 1) * REC;
                    const f32x4 nkk_n = *(const LAS f32x4*)(rn + kq * 4), wr_n = *(const LAS f32x4*)(rn + 64 + kq * 4), w_n = *(const LAS f32x4*)(rn + 128 + kq * 4), b_n = *(const LAS f32x4*)(rn + 192 + kq * 4), kp_n = *(const LAS f32x4*)(rn + 256 + kq * 4);
                    const float vv_n = rn[320 + myrow]; const f32x2 bk_n = *(const LAS f32x2*)(rn + 384);
                    f32x2 tp = S01 * (f32x2){nkk[0], nkk[1]}; tp = S23 * (f32x2){nkk[2], nkk[3]} + tp;
                    f32x2 tq = S01 * (f32x2){wr4[0], wr4[1]}; tq = S23 * (f32x2){wr4[2], wr4[3]} + tq;
                    float p = tp.x + tp.y, q = tq.x + tq.y;
                    p = dpp_allreduce16(p); q = dpp_allreduce16(q);
                    const f32x2 pp = {p, p}, v2 = {vv, vv};
                    S01 = S01 * (f32x2){w4[0], w4[1]} + ((f32x2){b4[0], b4[1]} * pp + (f32x2){kp4[0], kp4[1]} * v2);
                    S23 = S23 * (f32x2){w4[2], w4[3]} + ((f32x2){b4[2], b4[3]} * pp + (f32x2){kp4[2], kp4[3]} * v2);
                    const float o = q + p * bk.x + vv * bk.y;
                    osel = (kq == u) ? o : osel;
                    nkk = nkk_n; wr4 = wr_n; w4 = w_n; b4 = b_n; kp4 = kp_n; vv = vv_n; bk = bk_n;
                }
                op[(size_t)s16 * 512] = (bf16_t)(cvt_pk_bf16(osel, 0.f) & 0xffffu);
            }
            S = (f32x4){S01.x, S01.y, S23.x, S23.y};
            __syncthreads();
        }
        *(f32x4*)(P.out + O_WKVP + ((size_t)(hd * 64 + myrow)) * 64 + kq * 4) = S;
        __builtin_amdgcn_s_setprio(0);
    }
}

__device__ __forceinline__ void rwkv_sample(const Params& P, LAS unsigned char* lds, int i, int h) {
    unsigned char* ws = P.ws; const int tid = threadIdx.x;
    const bf16_t* F = (const bf16_t*)(ws + WS_RH + RH_F); const bf16_t* LOwa = (const bf16_t*)(ws + WS_RX); bf16_t* O = (bf16_t*)(ws + WS_RH + RH_AS5); float* BON = (float*)(ws + WS_BONUS);
    LAS float* rec = (LAS float*)lds; const size_t row = (size_t)MPROMPT + i;
    if (tid < 16) { const int l16 = tid, ch = h * 64 + l16 * 4; PrepC pc; load_prepc(pc, P, h, l16);
        const bf16_t* f = F + row * RC + ch; const float* sp = P.in[2] + (size_t)i * RC + ch; const bf16_t* l = LOwa + row * 1024 + ch;
        const float bon = prep_compute(pc, load4bf(f), load4bf(f + 512), load4bf(f + 1024), *(const f32x4*)sp, *(const f32x4*)(sp + 512), *(const f32x4*)(sp + 1024), load4bf(l), load4bf(l + 512), rec, l16);
        if (l16 == 0) BON[row * 8 + h] = bon; }
    __syncthreads();
    { const int v = tid >> 3, k0 = (tid & 7) * 8; const size_t so = ((size_t)((i * 8 + h) * 64 + v)) * 64 + k0;
      f32x4 S0 = *(const f32x4*)(P.in[3] + so), S1 = *(const f32x4*)(P.in[3] + so + 4);
      const f32x4 n0 = *(const LAS f32x4*)(rec + k0), n1 = *(const LAS f32x4*)(rec + k0 + 4), r0 = *(const LAS f32x4*)(rec + 64 + k0), r1 = *(const LAS f32x4*)(rec + 68 + k0);
      const f32x4 w0 = *(const LAS f32x4*)(rec + 128 + k0), w1 = *(const LAS f32x4*)(rec + 132 + k0), b0 = *(const LAS f32x4*)(rec + 192 + k0), b1 = *(const LAS f32x4*)(rec + 196 + k0), k0v = *(const LAS f32x4*)(rec + 256 + k0), k1v = *(const LAS f32x4*)(rec + 260 + k0);
      const float vv = rec[320 + v], br = rec[384], kr = rec[385];
      float p = 0.f, q = 0.f;
#pragma unroll
      for (int j = 0; j < 4; ++j) { p += S0[j] * n0[j] + S1[j] * n1[j]; q += S0[j] * r0[j] + S1[j] * r1[j]; }
      p += __shfl_xor(p, 1); p += __shfl_xor(p, 2); p += __shfl_xor(p, 4); q += __shfl_xor(q, 1); q += __shfl_xor(q, 2); q += __shfl_xor(q, 4);
      S0 = S0 * w0 + (b0 * p + k0v * vv); S1 = S1 * w1 + (b1 * p + k1v * vv);
      *(f32x4*)(P.out + O_WKVS + so) = S0; *(f32x4*)(P.out + O_WKVS + so + 4) = S1;
      if ((tid & 7) == 0) O[row * 512 + h * 64 + v] = (bf16_t)(cvt_pk_bf16(q + p * br + vv * kr, 0.f) & 0xffffu); }
    __syncthreads();
}

__device__ __forceinline__ void rwkv_sample4(const Params& P, LAS unsigned char* lds, int t0) {
    unsigned char* ws = P.ws; const int tid = threadIdx.x;
    const bf16_t* F = (const bf16_t*)(ws + WS_RH + RH_F); const bf16_t* LOwa = (const bf16_t*)(ws + WS_RX); bf16_t* O = (bf16_t*)(ws + WS_RH + RH_AS5); float* BON = (float*)(ws + WS_BONUS);
    const int v = tid >> 3, k0 = (tid & 7) * 8;
    f32x4 S0[4], S1[4];
#pragma unroll
    for (int j = 0; j < 4; ++j) { const int t = t0 + 256 * j; const size_t so = ((size_t)(t * 64 + v)) * 64 + k0; S0[j] = *(const f32x4*)(P.in[3] + so); S1[j] = *(const f32x4*)(P.in[3] + so + 4); }
    if (tid < 64) { const int j = tid >> 4, l16 = tid & 15, t = t0 + 256 * j, i = t >> 3, h = t & 7, ch = h * 64 + l16 * 4; const size_t row = (size_t)MPROMPT + i;
        PrepC pc; load_prepc(pc, P, h, l16);
        const bf16_t* f = F + row * RC + ch; const float* sp = P.in[2] + (size_t)i * RC + ch; const bf16_t* l = LOwa + row * 1024 + ch;
        const float bon = prep_compute(pc, load4bf(f), load4bf(f + 512), load4bf(f + 1024), *(const f32x4*)sp, *(const f32x4*)(sp + 512), *(const f32x4*)(sp + 1024), load4bf(l), load4bf(l + 512), (LAS float*)lds + j * 392, l16);
        if (l16 == 0) BON[row * 8 + h] = bon; }
    __syncthreads();
#pragma unroll
    for (int j = 0; j < 4; ++j) { const int t = t0 + 256 * j, i = t >> 3, h = t & 7; const size_t row = (size_t)MPROMPT + i; const size_t so = ((size_t)(t * 64 + v)) * 64 + k0; const LAS float* rec = (const LAS float*)lds + j * 392;
        const f32x4 n0 = *(const LAS f32x4*)(rec + k0), n1 = *(const LAS f32x4*)(rec + k0 + 4), r0 = *(const LAS f32x4*)(rec + 64 + k0), r1 = *(const LAS f32x4*)(rec + 68 + k0);
        const f32x4 w0 = *(const LAS f32x4*)(rec + 128 + k0), w1 = *(const LAS f32x4*)(rec + 132 + k0), b0 = *(const LAS f32x4*)(rec + 192 + k0), b1 = *(const LAS f32x4*)(rec + 196 + k0), k0v = *(const LAS f32x4*)(rec + 256 + k0), k1v = *(const LAS f32x4*)(rec + 260 + k0);
        const float vv = rec[320 + v], br = rec[384], kr = rec[385];
        float p = 0.f, q = 0.f;
#pragma unroll
        for (int e = 0; e < 4; ++e) { p += S0[j][e] * n0[e] + S1[j][e] * n1[e]; q += S0[j][e] * r0[e] + S1[j][e] * r1[e]; }
        p += __shfl_xor(p, 1); p += __shfl_xor(p, 2); p += __shfl_xor(p, 4); q += __shfl_xor(q, 1); q += __shfl_xor(q, 2); q += __shfl_xor(q, 4);
        *(f32x4*)(P.out + O_WKVS + so) = S0[j] * w0 + (b0 * p + k0v * vv); *(f32x4*)(P.out + O_WKVS + so + 4) = S1[j] * w1 + (b1 * p + k1v * vv);
        if ((tid & 7) == 0) O[row * 512 + h * 64 + v] = (bf16_t)(cvt_pk_bf16(q + p * br + vv * kr, 0.f) & 0xffffu); }
    __syncthreads();
}

__device__ __forceinline__ void s5_sample(const Params& P, int i, int g, int lane) {
    unsigned char* ws = P.ws; const float* Us = (const float*)(ws + WS_US); const float* abar = (const float*)(ws + WS_ABAR); const float* bbt = (const float*)(ws + WS_BBT); bf16_t* Z = (bf16_t*)(ws + WS_Z);
    const int gp = g * 64 + lane; const size_t so = (size_t)(i * 32 + g) * 64 + lane;
    const float x0r = P.in[4][so], x0i = P.in[5][so], ar = abar[gp * 2], ai = abar[gp * 2 + 1];
    float bur = 0.f, bui = 0.f; float uu[16];
#pragma unroll
    for (int h = 0; h < 16; ++h) { uu[h] = Us[(size_t)i * 512 + g * 16 + h]; bur += bbt[(gp * 16 + h) * 2] * uu[h]; bui += bbt[(gp * 16 + h) * 2 + 1] * uu[h]; }
    const float xr = ar * x0r - ai * x0i + bur, xi = ar * x0i + ai * x0r + bui;
    P.out[O_S5RS + so] = xr; P.out[O_S5IS + so] = xi;
    float mine = 0.f, myu = 0.f;
#pragma unroll
    for (int h = 0; h < 16; ++h) { float v = xr * P.in[28][(g * 16 + h) * 64 + lane] - xi * P.in[29][(g * 16 + h) * 64 + lane]; v = red64(v); if (lane == h) { mine = v; myu = uu[h]; } }
    if (lane < 16) { const float y = mine + P.in[30][g * 16 + lane] * myu; Z[((size_t)MPROMPT + i) * 512 + g * 16 + lane] = (bf16_t)(cvt_pk_bf16(geluf_(y), 0.f) & 0xffffu); }
}

__device__ __forceinline__ void phase_post(const Params& P) {
    unsigned char* ws = P.ws; const size_t gtid = (size_t)blockIdx.x * NTHR + threadIdx.x, gthreads = (size_t)gridDim.x * NTHR; const int l16 = threadIdx.x & 15;
    const bf16_t* F = (const bf16_t*)(ws + WS_RH + RH_F); const bf16_t* O = (const bf16_t*)(ws + WS_RH + RH_AS5); const bf16_t* LOg = (const bf16_t*)(ws + WS_WFFN); const float* BON = (const float*)(ws + WS_BONUS); bf16_t* YAB = (bf16_t*)(ws + WS_RX);
    const size_t ngrp = (size_t)MV * 8, gstride = gthreads >> 4;
    for (size_t grp0 = gtid >> 4; grp0 < ngrp; grp0 += 2 * gstride) {
        f32x4 o[2], fv[2], pv[2], g[2]; float bon[2]; int rowv[2], chv[2]; bool ok[2];
#pragma unroll
        for (int q = 0; q < 2; ++q) { const size_t grp = grp0 + q * gstride; ok[q] = grp < ngrp; const size_t gg = ok[q] ? grp : grp0; const int row = (int)(gg >> 3), h = (int)(gg & 7), ch = h * 64 + l16 * 4; rowv[q] = row; chv[q] = ch;
            o[q] = load4bf(O + (size_t)row * 512 + ch); fv[q] = load4bf(F + (size_t)row * RC + 1024 + ch);
            if (row < MPROMPT) { if ((row & 2047) > 0) pv[q] = load4bf(F + (size_t)(row - 1) * RC + 1024 + ch); else pv[q] = (f32x4){0.f, 0.f, 0.f, 0.f}; } else pv[q] = *(const f32x4*)(P.in[2] + (size_t)(row - MPROMPT) * RC + 1024 + ch);
            g[q] = load4bf(LOg + (size_t)row * 512 + ch); bon[q] = BON[(size_t)row * 8 + h]; }
#pragma unroll
        for (int q = 0; q < 2; ++q) { const int row = rowv[q], ch = chv[q];
            const float mean = red16((o[q][0] + o[q][1]) + (o[q][2] + o[q][3])) * (1.0f / 64.0f); const f32x4 d = o[q] - mean;
            const float var = red16((d[0] * d[0] + d[1] * d[1]) + (d[2] * d[2] + d[3] * d[3])) * (1.0f / 64.0f); const float rstd = rsqrtf(var + 64e-5f);
            const f32x4 muv = *(const f32x4*)(P.in[12] + 1024 + ch); const f32x4 v = fv[q] + muv * (pv[q] - fv[q]);
            const f32x4 lw = *(const f32x4*)(P.in[21] + ch), lb = *(const f32x4*)(P.in[22] + ch);
            const f32x4 ya = (d * rstd * lw + lb + v * bon[q]) * g[q];
            if (ok[q]) store4bf(YAB + (size_t)row * 1024 + ch, ya); }
    }
}


__device__ __forceinline__ void comb_resid(const float* slab, int S, const float* base_f32, float alpha, bf16_t* XHs, float* SSPs) {
    const int lane = threadIdx.x & 63, wave = threadIdx.x >> 6;
    for (int r = blockIdx.x * 8 + wave; r < NSAMP; r += gridDim.x * 8) { float ssq = 0.f;
#pragma unroll
        for (int i = 0; i < 4; ++i) { const int c = i * 256 + lane * 4; f32x4 a = {0.f, 0.f, 0.f, 0.f};
            for (int sl = 0; sl < S; ++sl) a += *(const f32x4*)(slab + ((size_t)(sl * 128 + r)) * 1024 + c);
            const f32x4 b = base_f32 ? *(const f32x4*)(base_f32 + (size_t)r * 1024 + c) : load4bf(XHs + (size_t)r * 2048 + c);
            const f32x4 o = b + a * alpha; store4bf(XHs + (size_t)r * 2048 + c, o);
            ssq += (o[0] * o[0] + o[1] * o[1]) + (o[2] * o[2] + o[3] * o[3]); }
        ssq = red64(ssq); if (lane < 16) SSPs[(size_t)r * 16 + lane] = lane == 0 ? ssq : 0.f; }
}
__device__ __forceinline__ void comb_gate(const float* slab, const bf16_t* Gt, bf16_t* Mg) {
    for (int i = blockIdx.x * NTHR + threadIdx.x; i < NSAMP * 256; i += gridDim.x * NTHR) { const int r = i >> 8, c = (i & 255) * 4; const size_t row = (size_t)MPROMPT + r;
        const f32x4 pa = *(const f32x4*)(slab + (size_t)r * 1024 + c) + *(const f32x4*)(slab + (size_t)(128 + r) * 1024 + c);
        const f32x4 pb = *(const f32x4*)(slab + (size_t)(256 + r) * 1024 + c) + *(const f32x4*)(slab + (size_t)(384 + r) * 1024 + c);
        const f32x4 ga = load4bf(Gt + row * 2048 + c), gb = load4bf(Gt + row * 2048 + 1024 + c);
        store4bf(Mg + row * 1024 + c, ga * pa + gb * pb); }
}

__device__ __forceinline__ void phase_final(const Params& P) {
    const float* ss = (const float*)(P.ws + WS_SS4); const float* slab = (const float*)(P.ws + WS_SLAB); const int lane = threadIdx.x & 63, wave = threadIdx.x >> 6;
    for (int row = MPROMPT + blockIdx.x * 8 + wave; row < MV; row += gridDim.x * 8) { float* x = P.out + (size_t)row * DM;
        if (row < MPROMPT) { const float s = row_rs(ss, row);
#pragma unroll
            for (int i = 0; i < 4; ++i) { const int c = i * 256 + lane * 4; const f32x4 v = *(const f32x4*)(x + c), gf = *(const f32x4*)(P.in[39] + c); *(f32x4*)(x + c) = v * s * gf; } }
        else { const int r = row - MPROMPT; f32x4 o[4]; float ssq = 0.f;
#pragma unroll
            for (int i = 0; i < 4; ++i) { const int c = i * 256 + lane * 4; f32x4 a = {0.f, 0.f, 0.f, 0.f};
                for (int sl = 0; sl < 11; ++sl) a += *(const f32x4*)(slab + ((size_t)(sl * 128 + r)) * 1024 + c);
                o[i] = load4bf((const bf16_t*)x + 1024 + c) + a * 0.5f; ssq += (o[i][0] * o[i][0] + o[i][1] * o[i][1]) + (o[i][2] * o[i][2] + o[i][3] * o[i][3]); }
            ssq = red64(ssq); const float s = rsqrtf(ssq * (1.0f / 1024.0f) + 1e-6f);
#pragma unroll
            for (int i = 0; i < 4; ++i) { const int c = i * 256 + lane * 4; const f32x4 gf = *(const f32x4*)(P.in[39] + c); *(f32x4*)(x + c) = o[i] * s * gf; } } }
}


#define XB_TMO      128
#define XB_XCNT(j)  (256  + 64 * (j))
#define XB_XSUB(j)  (1280 + 64 * (j))
#define XB_XGEN(j)  (2304 + 64 * (j))
#define XB_TOP      3328
#define XB_TOPGEN   3392
#define XCD_BAR_WORDS 3456
#define XB_SPIN_CAP (1u << 18)

__device__ __forceinline__ unsigned xb_ld(unsigned* p)              { return __hip_atomic_load(p, __ATOMIC_RELAXED, __HIP_MEMORY_SCOPE_AGENT); }
__device__ __forceinline__ unsigned xb_add(unsigned* p, unsigned v) { return __hip_atomic_fetch_add(p, v, __ATOMIC_RELAXED, __HIP_MEMORY_SCOPE_AGENT); }
__device__ __forceinline__ unsigned xb_xcc_id() { return (unsigned)__builtin_amdgcn_s_getreg((3 << 11) | 20) & 0xFu; }
#define XB_SPIN(cond, bar) do { unsigned _sp = 0; while (cond) { __builtin_amdgcn_s_sleep(1); \
    if ((++_sp & 255u) == 0u) { if (xb_ld(&(bar)[XB_TMO])) break; if (_sp > XB_SPIN_CAP) { atomicAdd(&(bar)[XB_TMO], 1u); break; } } } } while (0)

struct XcdBarrier {
    unsigned* bar; unsigned x;
    volatile LAS unsigned* st;
};

__device__ __forceinline__ XcdBarrier xcd_barrier_post(unsigned* bar, volatile LAS unsigned* st) {
    XcdBarrier b; b.bar = bar; b.x = xb_xcc_id(); b.st = st;
    if (threadIdx.x == 0) (void)xb_add(&bar[XB_XCNT(b.x)], 1u);
    return b;
}
__device__ __forceinline__ void xcd_barrier_complete(unsigned* bar, unsigned x, unsigned& nloc, unsigned& nx) {
    const unsigned G = gridDim.x * gridDim.y * gridDim.z;
    unsigned sum, cnt, mine, sp = 0u;
    for (;;) {
        sum = 0u; cnt = 0u; mine = 0u;
#pragma unroll
        for (unsigned j = 0; j < 16; ++j) { const unsigned c = xb_ld(&bar[XB_XCNT(j)]); sum += c; cnt += (c > 0u) ? 1u : 0u; mine = (j == x) ? c : mine; }
        if (sum == G) break;
        __builtin_amdgcn_s_sleep(1);
        if ((++sp & 255u) == 0u) { if (xb_ld(&bar[XB_TMO])) break; if (sp > XB_SPIN_CAP) { atomicAdd(&bar[XB_TMO], 1u); break; } }
    }
    nloc = mine > 0u ? mine : 1u; nx = cnt > 0u ? cnt : 1u;
}

__device__ __forceinline__ void xcd_barrier(const XcdBarrier& b) {
    asm volatile("s_waitcnt vmcnt(0)" ::: "memory");
    __syncthreads();
    if (threadIdx.x == 0) {
        unsigned* bar = b.bar;
        __builtin_amdgcn_s_waitcnt(0);
        unsigned nloc = b.st[0], nx = b.st[1];
        if (nloc == 0u) { xcd_barrier_complete(bar, b.x, nloc, nx); b.st[0] = nloc; b.st[1] = nx; }
        const unsigned old = xb_add(&bar[XB_XSUB(b.x)], 1u);
        const unsigned gen = old / nloc;
        if (old + 1u == (gen + 1u) * nloc) {
            __builtin_amdgcn_fence(__ATOMIC_RELEASE, "agent");
            asm volatile("s_waitcnt vmcnt(0)" ::: "memory");
            const unsigned og = xb_add(&bar[XB_TOP], 1u);
            const unsigned tg = og / nx;
            if (og + 1u == (tg + 1u) * nx) xb_add(&bar[XB_TOPGEN], 1u);
            else XB_SPIN(xb_ld(&bar[XB_TOPGEN]) == tg, bar);
            __builtin_amdgcn_fence(__ATOMIC_ACQUIRE, "agent");
            xb_add(&bar[XB_XGEN(b.x)], 1u);
            asm volatile("s_waitcnt vmcnt(0)" ::: "memory");
        } else {
            XB_SPIN(xb_ld(&bar[XB_XGEN(b.x)]) == gen, bar);
            __builtin_amdgcn_fence(__ATOMIC_ACQUIRE, "agent");
            asm volatile("s_waitcnt vmcnt(0)" ::: "memory");
        }
    }
    __syncthreads();
}


template <int ONE_LAUNCH> __global__ void __launch_bounds__(NTHR, 2) fwd_megakernel(Params P, int seg) {
    extern __shared__ __attribute__((aligned(16))) unsigned char lds_raw[];
    LAS unsigned char* lds = (LAS unsigned char*)lds_raw;
    volatile LAS unsigned* bst = (volatile LAS unsigned*)(lds + 131072);
    if (threadIdx.x < 2) bst[threadIdx.x] = 0u;
    __syncthreads();
    XcdBarrier xbar; xbar.bar = (unsigned*)(P.ws + WS_CTL); xbar.x = 0; xbar.st = bst;
    if (ONE_LAUNCH) xbar = xcd_barrier_post((unsigned*)(P.ws + WS_CTL), bst);
    unsigned char* ws = P.ws; const int G = gridDim.x, bid = blockIdx.x;
    bf16_t* RX = (bf16_t*)(ws + WS_RX); bf16_t* RH = (bf16_t*)(ws + WS_RH);
    bf16_t* Fb = (bf16_t*)(ws + WS_RH + RH_F); bf16_t* As5 = (bf16_t*)(ws + WS_RH + RH_AS5); bf16_t* Lin = (bf16_t*)(ws + WS_RH + RH_LIN);
    bf16_t* Tb = RH; bf16_t* Mg = (bf16_t*)(ws + WS_RH + RH_MG); bf16_t* Gt = (bf16_t*)(ws + WS_RG); bf16_t* Zb = (bf16_t*)(ws + WS_Z);
    float* SS2 = (float*)(ws + WS_SS2); float* SS3 = (float*)(ws + WS_SS3); float* SS4 = (float*)(ws + WS_SS4);
    StaticOrder so; float* SLAB = (float*)(ws + WS_SLAB); bf16_t* XH = (bf16_t*)P.out;
    int cur_seg = 0;
#define GSYNC() do { if (ONE_LAUNCH) xcd_barrier(xbar); else ++cur_seg; } while (0)
#define RUN (ONE_LAUNCH || cur_seg == seg)
#undef PH
#define PH(n) if (RUN)

    PH(0) phase_prep(P, lds);
    GSYNC();
    PH(1) { Gemm g{RX, (const bf16_t*)(ws + WS_WFFN), 1024, 1024, 1024}; so.init(65, 22, G, bid); EpiFfnUp e{RH, (const float*)(ws + WS_RS1), 0}; gemm_phase(lds, g, so, e);
            if (bid >= 150) conv_job(P, (LAS float*)lds, 3, bid - 150, G - 150); }
    GSYNC();
    PH(2) { Gemm g{RH, (const bf16_t*)(ws + WS_WDT), FF, FF, FF}; so.init(64, 4, G, bid); EpiResid e{RX, XH, SS2, 0.5f, 1}; gemm_phase(lds, g, so, e);
            Gemm gs{RH, (const bf16_t*)(ws + WS_WDT), FF, FF, 256}; SplitOrder sp{4, 11, 256, G, bid}; EpiSlab es{SLAB, 256}; gemm_phase(lds, gs, sp, es);
            if (bid >= 44) for (int j = 4; j < 8; ++j) conv_job(P, (LAS float*)lds, j, bid - 44, G - 44); }
    GSYNC();
    PH(2) comb_resid(SLAB, 11, P.in[1], 0.5f, XH + (size_t)MPROMPT * 2048 + 1024, SS2 + (size_t)MPROMPT * 16);
    GSYNC();
    PH(3) { Gemm g{XH + 1024, (const bf16_t*)(ws + WS_WIN), 2048, 1024, 1024}; so.init(65, 17, G, bid); EpiWin e{SS2, Fb, As5, (float*)(ws + WS_US), Gt}; gemm_phase(lds, g, so, e);
            if (bid >= 81) phase_prep2(P, lds, bid - 81, G - 81); }
    GSYNC();
    PH(4) { Gemm g{As5 + 128, (const bf16_t*)(ws + WS_S5W1), 384, 256, 256}; DiagOrder d{128, G, bid}; EpiS5a e{P.out + O_WKVS}; gemm_phase(lds, g, d, e);
            if (bid < 128) {
                asm volatile("s_waitcnt vmcnt(0)" ::: "memory"); __syncthreads();
                if (threadIdx.x < 128) phase_carry(P, 2 * (bid & 3) + (threadIdx.x >> 6), bid >> 2, threadIdx.x & 63); } }
    PH(5) { phase_mix(P);
            if (bid >= 128) for (int t = (bid - 128) * 8 + (threadIdx.x >> 6); t < NSAMP * 32; t += (G - 128) * 8) s5_sample(P, t >> 5, t & 31, threadIdx.x & 63); }
    GSYNC();
    PH(7) { Gemm g{As5, (const bf16_t*)(ws + WS_S5W2), 384, 384, 384}; DiagOrder d{128, G, bid}; EpiS5b e{As5, P.in[30], Zb}; gemm_phase(lds, g, d, e); }
    PH(8) { Gemm g{Lin, (const bf16_t*)(ws + WS_WL), 256, 256, 256}; so.init(65, 6, G, (bid + 128) % G); EpiLora e{RX, (bf16_t*)(ws + WS_WFFN)}; gemm_phase(lds, g, so, e); }
    GSYNC();
    PH(9) { rwkv_prompt(P, lds, bid >> 2, bid & 3);
        rwkv_sample4(P, lds, bid); }
    GSYNC();
    PH(11) { Gemm g{Zb, (const bf16_t*)(ws + WS_WGLU), 512, 512, 512}; so.init(65, 2, G, bid); EpiGlu e{Zb, RX}; gemm_phase(lds, g, so, e); }
    PH(12) phase_post(P);
    GSYNC();
    PH(13) { LAS float* tile = (LAS float*)lds;
      if (bid >= 16) for (int j = 8; j < 11; ++j) conv_job(P, tile, j, bid - 16, G - 16); }
    PH(14) { Gemm g{RX, (const bf16_t*)(ws + WS_WA), 1024, 512, 512}; so.init(64, 4, G, bid); AccT gacc; EpiGateRatio e{Gt}; gemm_phase_acc(lds, g, so, e, gacc, true);
             Gemm g2{RX + 512, (const bf16_t*)(ws + WS_WB), 1024, 512, 512}; EpiGateOut e2{Gt, Mg}; gemm_phase_acc(lds, g2, so, e2, gacc, false);
             Gemm ga{RX, (const bf16_t*)(ws + WS_WA), 1024, 512, 256}; SplitOrder spa{4, 2, 256, G, bid}; EpiSlab ea{SLAB, 256}; gemm_phase(lds, ga, spa, ea);
             Gemm gb{RX + 512, (const bf16_t*)(ws + WS_WB), 1024, 512, 256}; SplitOrder spb{4, 2, 256, G, (bid + G - 8) % G}; EpiSlab eb{SLAB + (size_t)256 * 1024, 256}; gemm_phase(lds, gb, spb, eb); }
    GSYNC();
    PH(15) comb_gate(SLAB, Gt, Mg);
    GSYNC();
    PH(16) { Gemm g{Mg, (const bf16_t*)(ws + WS_WOUT), 1024, 1024, 1024}; so.init(64, 4, G, bid); EpiResid e{RX, XH, SS3, 1.0f, 0}; gemm_phase(lds, g, so, e);
             Gemm gs{Mg, (const bf16_t*)(ws + WS_WOUT), 1024, 1024, 256}; SplitOrder sp{4, 4, 256, G, bid}; EpiSlab es{SLAB, 256}; gemm_phase(lds, gs, sp, es); }
    GSYNC();
    PH(16) comb_resid(SLAB, 4, nullptr, 1.0f, XH + (size_t)MPROMPT * 2048 + 1024, SS3 + (size_t)MPROMPT * 16);
    GSYNC();
    PH(17) { Gemm g{XH + 1024, (const bf16_t*)(ws + WS_WFFN), 2048, 1024, 1024}; so.init(65, 22, G, bid); EpiFfnUp e{RH, SS3, 1}; gemm_phase(lds, g, so, e); }
    GSYNC();
    PH(18) { Gemm g{RH, (const bf16_t*)(ws + WS_WDT), FF, FF, FF}; so.init(64, 4, G, bid); EpiFinal e{P.out, P.in[39], (float*)(ws + WS_XSLOT), (unsigned*)(ws + WS_PCNT)}; gemm_phase(lds, g, so, e);
             Gemm gs{RH, (const bf16_t*)(ws + WS_WDT), FF, FF, 256}; SplitOrder sp{4, 11, 256, G, bid}; EpiSlab es{SLAB, 256}; gemm_phase(lds, gs, sp, es); }
    GSYNC();
    PH(19) phase_final(P);
}

extern "C" void kernel_launch(void* const* d_in, const int* in_sizes, int n_in, void* d_out, int out_size, void* d_ws, size_t ws_size, hipStream_t stream) {
    static int grid_blocks = 0;
    if (grid_blocks == 0) {
        if (n_in != 40 || ws_size < WS_END) { fprintf(stderr, "kernel_launch: unexpected n_in %d / ws_size %zu (need %zu)\n", n_in, ws_size, (size_t)WS_END); grid_blocks = -1; return; }
        int dev = 0, cus = 0;
        (void)hipGetDevice(&dev); (void)hipDeviceGetAttribute(&cus, hipDeviceAttributeMultiprocessorCount, dev);
        if (hipFuncSetAttribute((const void*)fwd_megakernel<1>, hipFuncAttributeMaxDynamicSharedMemorySize, LDS_BYTES) != hipSuccess) { fprintf(stderr, "hipFuncSetAttribute failed\n"); grid_blocks = -1; return; }
        (void)hipGetLastError();
        grid_blocks = cus > 256 ? 256 : cus;
    }
    if (grid_blocks < 0) return;
    Params p{};
    for (int i = 0; i < 40; ++i) p.in[i] = (const float*)d_in[i];
    p.out = (float*)d_out; p.ws = (unsigned char*)d_ws;
    if (hipMemsetAsync((char*)d_ws + WS_CTL, 0, 32768, stream) != hipSuccess) { fprintf(stderr, "memset failed\n"); return; }
    int seg = 0; void* args[] = {&p, &seg};
    hipError_t e = hipLaunchCooperativeKernel((const void*)fwd_megakernel<1>, dim3(grid_blocks), dim3(NTHR), args, LDS_BYTES, stream);
    if (e != hipSuccess) fprintf(stderr, "cooperative launch failed: %s (grid %d)\n", hipGetErrorString(e), grid_blocks);
}
```
